# Optimizing an MI355X kernel written in HIP

```python
import math
import jax, jax.numpy as jnp
from jax import lax
import numpy as np

D_MODEL = 2048
BATCH = 16
SEQ = 2048
DEPTH = 2
DEC_BATCH = 32
DEC_SEQ = 64
PAST_LEN = 2048

CHUNK = 64
PLE_DIM = 256
D_FF = 5632
N_EVEN = (DEPTH + 1) // 2
N_ODD = DEPTH // 2
POOL_WINDOWS = (2, 4, 8, 16)
POOL_WIDTH = D_MODEL // 4
POOL_GROUP_DIM = POOL_WIDTH // len(POOL_WINDOWS)
POOL_HIST = max(POOL_WINDOWS) - 1
DA_VDIM = 128
DA_HALF = DA_VDIM // 2
DA_WIDTH = D_MODEL - POOL_WIDTH
DA_HEADS = DA_WIDTH // DA_VDIM
N_BUCKETS = 32
MAX_DISTANCE = 128
IN_EVEN = POOL_WIDTH + 3 * DA_WIDTH
HG_DK = 128
HG_DV = 128
HG_WIDTH = D_MODEL
HG_HEADS = HG_WIDTH // HG_DK
IN_ODD = 4 * HG_WIDTH
REC_BLOCK = 16
ALPHA = (2 * DEPTH) ** 0.25
BETA = (8 * DEPTH) ** -0.25
EPS = 1e-5
NEG = -1e30

kernel_name = 'hybrid_stream_pool_diffattn_hgrn2_step'


def layer_norm(x, g, b):
    xf = x.astype(jnp.float32)
    mu = jnp.mean(xf, axis=-1, keepdims=True)
    var = jnp.mean(jnp.square(xf - mu), axis=-1, keepdims=True)
    y = (xf - mu) * lax.rsqrt(var + EPS) * g.astype(jnp.float32) + b.astype(jnp.float32)
    return y.astype(x.dtype)


def rms_norm(x, g):
    xf = x.astype(jnp.float32)
    return xf * lax.rsqrt(jnp.mean(jnp.square(xf), axis=-1, keepdims=True) + EPS) * g.astype(jnp.float32)


def swiglu(x, wg, wu, wd):
    return (jax.nn.silu(x @ wg) * (x @ wu)) @ wd


def t5_bucket(rel):
    nb = N_BUCKETS // 2
    max_exact = nb // 2
    n = jnp.abs(rel)
    nf = jnp.maximum(n, 1).astype(jnp.float32)
    large = max_exact + (jnp.log(nf / max_exact) / math.log(MAX_DISTANCE / max_exact)
                         * (nb - max_exact)).astype(jnp.int32)
    large = jnp.minimum(large, nb - 1)
    return jnp.where(rel > 0, nb, 0) + jnp.where(n < max_exact, n, large)


def pool_mixer(u, hist, start_pos, w_grp, scale):
    B, L, _ = u.shape
    full = jnp.concatenate([hist, u], axis=1).astype(jnp.float32)
    cs = jnp.cumsum(full, axis=1)
    cs = jnp.concatenate([jnp.zeros_like(cs[:, :1]), cs], axis=1)
    pos = start_pos + jnp.arange(L)
    outs = []
    for g, w in enumerate(POOL_WINDOWS):
        sl = slice(g * POOL_GROUP_DIM, (g + 1) * POOL_GROUP_DIM)
        s = cs[:, POOL_HIST + 1:POOL_HIST + 1 + L, sl] - cs[:, POOL_HIST + 1 - w:POOL_HIST + 1 - w + L, sl]
        cnt = jnp.minimum(pos + 1, w).astype(jnp.float32)[None, :, None]
        outs.append(s / cnt - full[:, POOL_HIST:, sl])
    pooled = jnp.stack(outs, axis=2)
    y = jnp.einsum('blgc,gcd->blgd', pooled, w_grp.astype(jnp.float32)).reshape(B, L, POOL_WIDTH)
    y = y * scale.astype(jnp.float32)
    return y.astype(u.dtype), full[:, -POOL_HIST:].astype(u.dtype)


def diff_attention(q1, q2, k1, k2, v, q_pos, k_pos, rel_bias, lam):
    B, Lq, H, _ = q1.shape
    bq = 128 if Lq % 128 == 0 else Lq
    nb = Lq // bq
    scale = DA_HALF ** -0.5
    k_chunk = k_pos // CHUNK

    def blocks(t):
        return t.reshape(B, nb, bq, *t.shape[2:]).swapaxes(0, 1)

    def one(args):
        qb1, qb2, qp = args
        rel = k_pos[None, :] - qp[:, None]
        bias = rel_bias[t5_bucket(rel)].transpose(2, 0, 1).astype(jnp.float32)
        mask = k_chunk[None, :] <= (qp // CHUNK)[:, None]

        def probs(qb, k):
            s = jnp.einsum('bqhd,bkhd->bhqk', qb, k).astype(jnp.float32) * scale + bias
            return jax.nn.softmax(jnp.where(mask, s, NEG), axis=-1)

        a = probs(qb1, k1) - lam * probs(qb2, k2)
        return jnp.einsum('bhqk,bkhe->bqhe', a.astype(v.dtype), v)

    o = lax.map(one, (blocks(q1), blocks(q2), q_pos.reshape(nb, bq)))
    return o.swapaxes(0, 1).reshape(B, Lq, H, v.shape[-1])


def even_mixer(x, k_cache, v_cache, pool_hist, layer_idx, w_in, w_out, pool_w, pool_scale,
               lam_q1, lam_k1, lam_q2, lam_k2, norm_g, rel_bias):
    B, L, _ = x.shape
    h = x @ w_in
    u = h[..., :POOL_WIDTH]
    q = h[..., POOL_WIDTH:POOL_WIDTH + DA_WIDTH].reshape(B, L, DA_HEADS, 2 * DA_HALF)
    k = h[..., POOL_WIDTH + DA_WIDTH:POOL_WIDTH + 2 * DA_WIDTH].reshape(B, L, DA_HEADS, 2 * DA_HALF)
    v = h[..., POOL_WIDTH + 2 * DA_WIDTH:].reshape(B, L, DA_HEADS, DA_VDIM)
    past = k_cache.shape[1]
    pool_out, new_hist = pool_mixer(u, pool_hist, past, pool_w, pool_scale)
    k_all = jnp.concatenate([k_cache, k], axis=1)
    v_all = jnp.concatenate([v_cache, v], axis=1)
    q_pos = past + jnp.arange(L, dtype=jnp.int32)
    k_pos = jnp.arange(past + L, dtype=jnp.int32)
    lam_init = 0.8 - 0.6 * math.exp(-0.3 * layer_idx)
    f32 = jnp.float32
    lam = (jnp.exp(jnp.sum(lam_q1.astype(f32) * lam_k1.astype(f32)))
           - jnp.exp(jnp.sum(lam_q2.astype(f32) * lam_k2.astype(f32))) + lam_init)
    o = diff_attention(q[..., :DA_HALF], q[..., DA_HALF:], k_all[..., :DA_HALF], k_all[..., DA_HALF:],
                       v_all, q_pos, k_pos, rel_bias, lam)
    o = (rms_norm(o, norm_g) * (1.0 - lam_init)).reshape(B, L, DA_WIDTH).astype(x.dtype)
    mix = jnp.concatenate([pool_out, o], axis=-1) @ w_out
    return mix, k, v, new_hist


def hgrn_scan(q, k, v, log_f, s0):
    B, L, H, DK = q.shape
    DV = v.shape[-1]
    blk = max(d for d in range(1, REC_BLOCK + 1) if L % d == 0)
    n = L // blk
    causal = jnp.tril(jnp.ones((blk, blk), bool))[None, :, :, None, None]

    def blocks(t):
        return t.reshape(B, n, blk, H, t.shape[-1]).swapaxes(0, 1)

    def step(S, inp):
        qc, kc, vc, gc = inp
        b = jnp.cumsum(gc, axis=1)
        o_inter = jnp.einsum('bthd,bhde->bthe', qc * jnp.exp(b), S)
        dec = jnp.exp(jnp.where(causal, b[:, :, None] - b[:, None, :], -jnp.inf))
        A = jnp.einsum('btshd,bshd->bhts', qc[:, :, None] * dec, kc)
        o_intra = jnp.einsum('bhts,bshe->bthe', A, vc)
        b_last = b[:, -1]
        S = (jnp.exp(b_last)[..., None] * S
             + jnp.einsum('bshd,bshe->bhde', kc * jnp.exp(b_last[:, None] - b), vc))
        return S, o_inter + o_intra

    S, o = lax.scan(step, s0, (blocks(q), blocks(k), blocks(v), blocks(log_f)))
    return o.swapaxes(0, 1).reshape(B, L, H, DV), S


def odd_mixer(x, s0, w_in, w_out, norm_g, lb):
    B, L, _ = x.shape
    f32 = jnp.float32
    h = (x @ w_in).reshape(B, L, 4, HG_HEADS, HG_DK)
    q = jax.nn.silu(h[:, :, 0].astype(f32))
    z = h[:, :, 1].astype(f32)
    inp = h[:, :, 2].astype(f32)
    gate = jax.nn.silu(h[:, :, 3].astype(f32))
    lb = lb.reshape(HG_HEADS, HG_DK)
    log_1mlb = jnp.log1p(-lb)
    log_f = jnp.logaddexp(jnp.log(lb), log_1mlb + jax.nn.log_sigmoid(z))
    k = jnp.exp(log_1mlb + jax.nn.log_sigmoid(-z))
    o, S = hgrn_scan(q, k, inp, log_f, s0.astype(f32))
    o = (rms_norm(o, norm_g) * gate).reshape(B, L, HG_WIDTH).astype(x.dtype)
    return o @ w_out, S.astype(x.dtype)


def trunk(x, p, k_cache, v_cache, pool_hist, hg_state, ln_g, ln_b, w_ffn_gate, w_ffn_up, w_ffn_down,
          w_ple_gate, w_ple_up, w_in_even, w_out_even, pool_w, pool_scale, lam_q1, lam_k1, lam_q2, lam_k2,
          diff_norm_g, rel_bias, w_in_odd, w_out_odd, hgrn_norm_g, lb_all):
    new_k, new_v, new_pool, new_s = [], [], [], []
    for i in range(DEPTH):
        x = layer_norm(ALPHA * x + 0.5 * swiglu(x, w_ffn_gate[i, 0], w_ffn_up[i, 0], w_ffn_down[i, 0]),
                       ln_g[i, 0], ln_b[i, 0])
        if i % 2 == 0:
            e = i // 2
            mix, k, v, ph = even_mixer(x, k_cache[e], v_cache[e], pool_hist[e], i, w_in_even[e], w_out_even[e],
                                       pool_w[e], pool_scale[e], lam_q1[e], lam_k1[e], lam_q2[e], lam_k2[e],
                                       diff_norm_g[e], rel_bias)
            new_k.append(k)
            new_v.append(v)
            new_pool.append(ph)
        else:
            o = i // 2
            mix, s = odd_mixer(x, hg_state[o], w_in_odd[o], w_out_odd[o], hgrn_norm_g[o], lb_all[i])
            new_s.append(s)
        x = layer_norm(ALPHA * x + mix, ln_g[i, 1], ln_b[i, 1])
        x = layer_norm(ALPHA * x + 0.5 * swiglu(x, w_ffn_gate[i, 1], w_ffn_up[i, 1], w_ffn_down[i, 1]),
                       ln_g[i, 2], ln_b[i, 2])
        x = x + jax.nn.sigmoid(x @ w_ple_gate[i]) * (p[i] @ w_ple_up[i])
    return x, jnp.stack(new_k), jnp.stack(new_v), jnp.stack(new_pool), jnp.stack(new_s)


def setup_inputs(seed: int = 0) -> dict:
    key = jax.random.key(seed)
    ks = iter(jax.random.split(key, 40))

    def nrm(shape, scale):
        return jax.random.normal(next(ks), shape, jnp.float32) * scale

    D = D_MODEL
    return {
        'x_prompt': nrm((BATCH, SEQ, D), 1.0),
        'x_sample': nrm((DEC_BATCH, DEC_SEQ, D), 1.0),
        'cache_diff_k': nrm((N_EVEN, DEC_BATCH, PAST_LEN, DA_HEADS, 2 * DA_HALF), 1.0),
        'cache_diff_v': nrm((N_EVEN, DEC_BATCH, PAST_LEN, DA_HEADS, DA_VDIM), 1.0),
        'state_pool': nrm((N_EVEN, DEC_BATCH, POOL_HIST, POOL_WIDTH), 1.0),
        'state_hgrn': nrm((N_ODD, DEC_BATCH, HG_HEADS, HG_DK, HG_DV), 0.5),
        'p_prompt': nrm((DEPTH, BATCH, SEQ, PLE_DIM), 1.0),
        'p_sample': nrm((DEPTH, DEC_BATCH, DEC_SEQ, PLE_DIM), 1.0),
        'ln_g': 1.0 + nrm((DEPTH, 3, D), 0.05),
        'ln_b': nrm((DEPTH, 3, D), 0.02),
        'w_ffn_gate': nrm((DEPTH, 2, D, D_FF), D ** -0.5),
        'w_ffn_up': nrm((DEPTH, 2, D, D_FF), D ** -0.5),
        'w_ffn_down': nrm((DEPTH, 2, D_FF, D), D_FF ** -0.5 * BETA),
        'w_ple_gate': nrm((DEPTH, D, D), D ** -0.5),
        'w_ple_up': nrm((DEPTH, PLE_DIM, D), PLE_DIM ** -0.5),
        'w_in_even': nrm((N_EVEN, D, IN_EVEN), D ** -0.5),
        'w_out_even': nrm((N_EVEN, POOL_WIDTH + DA_WIDTH, D), (POOL_WIDTH + DA_WIDTH) ** -0.5 * BETA),
        'pool_w': nrm((N_EVEN, len(POOL_WINDOWS), POOL_GROUP_DIM, POOL_GROUP_DIM), POOL_GROUP_DIM ** -0.5),
        'pool_scale': 1.0 + nrm((N_EVEN, POOL_WIDTH), 0.1),
        'lam_q1': nrm((N_EVEN, DA_HALF), 0.1),
        'lam_k1': nrm((N_EVEN, DA_HALF), 0.1),
        'lam_q2': nrm((N_EVEN, DA_HALF), 0.1),
        'lam_k2': nrm((N_EVEN, DA_HALF), 0.1),
        'diff_norm_g': 1.0 + nrm((N_EVEN, DA_VDIM), 0.05),
        'rel_bias': nrm((N_BUCKETS, DA_HEADS), 0.5),
        'w_in_odd': nrm((N_ODD, D, IN_ODD), D ** -0.5),
        'w_out_odd': nrm((N_ODD, HG_WIDTH, D), HG_WIDTH ** -0.5 * BETA),
        'hgrn_norm_g': 1.0 + nrm((N_ODD, HG_DV), 0.05),
        'hgrn_lb_logits': nrm((DEPTH, HG_WIDTH), 0.5),
    }


def reference(x_prompt, x_sample, cache_diff_k, cache_diff_v, state_pool, state_hgrn, p_prompt, p_sample,
              ln_g, ln_b, w_ffn_gate, w_ffn_up, w_ffn_down, w_ple_gate, w_ple_up, w_in_even, w_out_even,
              pool_w, pool_scale, lam_q1, lam_k1, lam_q2, lam_k2, diff_norm_g, rel_bias, w_in_odd, w_out_odd,
              hgrn_norm_g, hgrn_lb_logits):
    lbp = jax.nn.softmax(hgrn_lb_logits.astype(jnp.float32), axis=0)
    lb_all = jnp.cumsum(lbp, axis=0) - lbp[0]
    weights = (ln_g, ln_b, w_ffn_gate, w_ffn_up, w_ffn_down, w_ple_gate, w_ple_up, w_in_even, w_out_even,
               pool_w, pool_scale, lam_q1, lam_k1, lam_q2, lam_k2, diff_norm_g, rel_bias, w_in_odd, w_out_odd,
               hgrn_norm_g, lb_all)
    B = x_prompt.shape[0]
    dt = x_prompt.dtype
    empty_k = jnp.zeros((N_EVEN, B, 0, DA_HEADS, 2 * DA_HALF), dt)
    empty_v = jnp.zeros((N_EVEN, B, 0, DA_HEADS, DA_VDIM), dt)
    zero_pool = jnp.zeros((N_EVEN, B, POOL_HIST, POOL_WIDTH), dt)
    zero_s = jnp.zeros((N_ODD, B, HG_HEADS, HG_DK, HG_DV), dt)
    y_prompt, k_p, v_p, pool_p, s_p = trunk(x_prompt, p_prompt, empty_k, empty_v, zero_pool, zero_s, *weights)
    y_sample, k_s, v_s, pool_s, s_s = trunk(x_sample, p_sample, cache_diff_k, cache_diff_v, state_pool,
                                            state_hgrn, *weights)
    return (y_prompt, y_sample, k_p, v_p, k_s, v_s, pool_p, pool_s, s_p, s_s)
```

```cpp
#include <hip/hip_runtime.h>
#include <cstdio>
#include <cstdint>

#ifndef MK_ONE_LAUNCH
#define MK_ONE_LAUNCH 1
#endif

#define LAS __attribute__((address_space(3)))
#define GAS __attribute__((address_space(1)))
typedef unsigned short bf16_t;
typedef short bf16x8 __attribute__((ext_vector_type(8)));
typedef short s16x4 __attribute__((ext_vector_type(4)));
typedef float f32x2 __attribute__((ext_vector_type(2)));
typedef float f32x4 __attribute__((ext_vector_type(4)));
typedef float f32x16 __attribute__((ext_vector_type(16)));
typedef unsigned u32x2 __attribute__((ext_vector_type(2)));
typedef unsigned u32x4 __attribute__((ext_vector_type(4)));

constexpr int D = 2048, FF = 5632, MP = 32768, MS = 2048, M = MP + MS, SEQ = 2048, DSEQ = 64, NB_P = 16, NB_S = 32, PAST = 2048;
constexpr int PLE = 256, POOLW = 512, DAW = 1536, NH = 12, HD = 128, IN_EVEN = 5120, IN_ODD = 8192, HGH = 16;
constexpr float ALPHA = 1.4142135623730951f, LN_EPS = 1e-5f, LOG2E = 1.4426950408889634f;
constexpr float QSCALE = 0.125f * LOG2E;
constexpr float LAM_INIT = 0.2f;

constexpr size_t MiB = 1u << 20;
constexpr size_t WS_CTL = 0, CTL_ZERO_BYTES = 1 * MiB;
constexpr size_t WS_TAB = 1 * MiB;
constexpr size_t TAB_BIAS = 0;
constexpr size_t TAB_LB = 16384;
constexpr size_t TAB_PWT = 65536;
constexpr size_t WS_WGU = 2 * MiB;
constexpr size_t WS_WD = WS_WGU + 176 * MiB;
constexpr size_t WS_WINE = WS_WD + 88 * MiB;
constexpr size_t WS_WOUTE = WS_WINE + 20 * MiB;
constexpr size_t WS_WINO = WS_WOUTE + 8 * MiB;
constexpr size_t WS_WOUTO = WS_WINO + 32 * MiB;
constexpr size_t WS_WPG = WS_WOUTO + 8 * MiB;
constexpr size_t WS_WPU = WS_WPG + 16 * MiB;
constexpr size_t WS_X = WS_WPU + 2 * MiB;
constexpr size_t WS_XB = WS_X + 272 * MiB;
constexpr size_t WS_PB = WS_XB + 136 * MiB;
constexpr size_t WS_R = WS_PB + 34 * MiB;
constexpr size_t WS_H = WS_R;
constexpr size_t WS_PU = WS_R;
constexpr size_t WS_U = WS_R;
constexpr size_t WS_QB = WS_U + 68 * MiB;
constexpr size_t WS_KB = WS_QB + 102 * MiB;
constexpr size_t WS_VB = WS_KB + 96 * MiB;
constexpr size_t WS_MIX = WS_R + 816 * MiB;
constexpr size_t WS_Q2 = WS_R;
constexpr size_t WS_KK = WS_Q2 + 136 * MiB;
constexpr size_t WS_VV = WS_KK + 136 * MiB;
constexpr size_t WS_GG = WS_VV + 136 * MiB;
constexpr size_t WS_FD = WS_GG + 136 * MiB;
static_assert(WS_FD + 272 * MiB == WS_MIX && WS_VB + 96 * MiB <= WS_MIX && WS_H + 374 * MiB <= WS_MIX, "overlay map");
constexpr size_t WS_END = WS_MIX + 136 * MiB;

constexpr int CW_BAR = 4096;
constexpr int CW_QATT = 64;

constexpr int LDS_BYTES = 147456;
constexpr int LDS_ATAB = 131072;
constexpr int LDS_MISC = 139264;

__device__ __forceinline__ unsigned cvt_pk_bf16(float lo, float hi) { unsigned r; asm volatile("v_cvt_pk_bf16_f32 %0, %1, %2" : "=v"(r) : "v"(lo), "v"(hi)); return r; }
__device__ __forceinline__ float bf2f(unsigned short b) { return __builtin_bit_cast(float, (unsigned)b << 16); }
__device__ __forceinline__ float bflo(unsigned w) { return __builtin_bit_cast(float, w << 16); }
__device__ __forceinline__ float bfhi(unsigned w) { return __builtin_bit_cast(float, w & 0xffff0000u); }
__device__ __forceinline__ float fast_exp2(float x) { return __builtin_amdgcn_exp2f(x); }
__device__ __forceinline__ float fast_rcp(float x) { return __builtin_amdgcn_rcpf(x); }
__device__ __forceinline__ float sigmoidf_(float x) { return fast_rcp(1.f + fast_exp2(-x * LOG2E)); }
__device__ __forceinline__ float wave_sum(float v) {
#pragma unroll
    for (int o = 1; o < 64; o <<= 1) v += __shfl_xor(v, o);
    return v;
}
#define LDS_WAIT() asm volatile("s_waitcnt lgkmcnt(0)" ::: "memory")
#define VM_WAIT() asm volatile("s_waitcnt vmcnt(0)" ::: "memory")

namespace pg8 {
constexpr int BM = 256, BK = 64, HALF = 128, HTB = HALF * BK * 2, STAGE_BYTES = 8 * HTB, NXCD = 8, WGM = 8;
__host__ __device__ __forceinline__ int lds_byte(int r, int c) { const int st = (r >> 4) * 2 + (c >> 5), rr = r & 15, cc = c & 31, ob = rr * 64 + cc * 2; return st * 1024 + (ob ^ (((ob >> 9) & 1) << 5)); }
__host__ __device__ __forceinline__ void stage_rc(int b, int& R, int& C) { const int st = b / 1024, sb = b % 1024, swz = sb ^ (((sb >> 9) & 1) << 5); R = (st >> 1) * 16 + swz / 64; C = (st & 1) * 32 + (swz % 64) / 2; }
__host__ __device__ __forceinline__ int perm32(int rho) { const int n = rho >> 4, i = rho & 15; return 8 * (i >> 2) + 4 * n + (i & 3); }
struct Unit { int pm, pn; };
struct Gemm { const bf16_t* A; const bf16_t* Bt; int M, N, K; };
struct StaticOrder {
    int nM, nN, nwg, G, c;
    __host__ __device__ void init(int M_, int N_, int G_, int c_) { nM = M_ / BM; nN = N_ / BM; nwg = nM * nN; G = G_; c = c_; }
    __host__ __device__ bool next(int i, Unit& u) const {
        const long L = (long)i * G + c; if (L >= nwg) return false;
        int wgid = (int)L; { const int q = nwg / NXCD, r = nwg % NXCD, xcd = wgid % NXCD, off = wgid / NXCD; wgid = (xcd < r ? xcd * (q + 1) : r * (q + 1) + (xcd - r) * q) + off; }
        const int nig = WGM * nN, gid = wgid / nig, fm = gid * WGM, gsz = (nM - fm) < WGM ? (nM - fm) : WGM;
        u.pm = fm + ((wgid % nig) % gsz); u.pn = (wgid % nig) / gsz; return true;
    }
    __device__ __forceinline__ void a_ready(const Unit&) const {}
    __device__ __forceinline__ void done(const Unit&) const {}
};

template <class Epi, class Sched, bool ALIGN_EPI = false, bool SP2 = false>
__device__ __forceinline__ void gemm_phase(LAS unsigned char* lds, const Gemm g, const Sched& S, const Epi& E) {
    int tid = threadIdx.x; asm volatile("" : "+v"(tid));
    const int wid = __builtin_amdgcn_readfirstlane(tid >> 6), lane = tid & 63, wr = wid >> 2, wc = wid & 3, fr = lane & 15, fq = lane >> 4;
    int K = g.K; asm volatile("" : "+s"(K));
    const int nt = K / BK;
    unsigned voffA[2], voffB[2];
#pragma unroll
    for (int i = 0; i < 2; ++i) { int R, C; stage_rc(tid * 16 + i * 8192, R, C); const int Rb = Epi::PERM ? ((R & ~31) + perm32(R & 31)) : R;
        voffA[i] = (unsigned)(R * K + C) * 2u; voffB[i] = (unsigned)(Rb * K + C) * 2u; }
    const size_t kstep = (size_t)(BK * 2);
    const size_t hstep = (size_t)HALF * K * 2;
    const size_t tstep = 2 * hstep;
    const unsigned ldsw = (unsigned)wid * 1024u;
    const int aoff = lds_byte(wr * 64 + fr, fq * 8), boff = lds_byte(wc * 32 + fr, fq * 8);
#define PG8_SA(b, h) (((b) * 2 + (h)) * HTB)
#define PG8_SB(b, h) ((4 + (b) * 2 + (h)) * HTB)
#define PG8_STAGE(bufoff, gbase, voff) do { _Pragma("unroll") for (int _i = 0; _i < 2; ++_i) \
        __builtin_amdgcn_global_load_lds((const unsigned*)((const char*)(gbase) + (voff)[_i]), (LAS unsigned*)(lds + (bufoff) + ldsw + _i * 8192), 16, 0, 0); } while (0)
#define PG8_LDA(dst, b, h) do { _Pragma("unroll") for (int m = 0; m < 4; ++m) _Pragma("unroll") for (int k = 0; k < 2; ++k) dst[m][k] = *(const LAS bf16x8*)(lds + PG8_SA(b, h) + aoff + m * 2048 + k * 1024); } while (0)
#define PG8_LDB(dst, b, h) do { _Pragma("unroll") for (int n = 0; n < 2; ++n) _Pragma("unroll") for (int k = 0; k < 2; ++k) dst[n][k] = *(const LAS bf16x8*)(lds + PG8_SB(b, h) + boff + n * 2048 + k * 1024); } while (0)
#define PG8_MMA(ai, bj, At, Bt) do { __builtin_amdgcn_s_setprio(1); _Pragma("unroll") for (int m = 0; m < 4; ++m) _Pragma("unroll") for (int n = 0; n < 2; ++n) _Pragma("unroll") for (int k = 0; k < 2; ++k) \
        acc[ai][bj][m][n] = __builtin_amdgcn_mfma_f32_16x16x32_bf16(Bt[n][k], At[m][k], acc[ai][bj][m][n], 0, 0, 0); __builtin_amdgcn_s_setprio(0); } while (0)
#define PG8_WAIT_V(n) asm volatile("s_waitcnt vmcnt(" #n ")" ::: "memory")
#define PG8_WAIT_L(n) asm volatile("s_waitcnt lgkmcnt(" #n ")" ::: "memory")
#define PG8_BAR __builtin_amdgcn_s_barrier()
#define PG8_SCHED __builtin_amdgcn_sched_barrier(0)
    Unit cur, nxt; int ui = 0;
    if (!S.next(0, cur)) return;
    f32x4 acc[2][2][4][2];
#pragma unroll
    for (int a = 0; a < 2; ++a)
#pragma unroll
        for (int b = 0; b < 2; ++b)
#pragma unroll
            for (int m = 0; m < 4; ++m)
#pragma unroll
                for (int n = 0; n < 2; ++n) acc[a][b][m][n] = (f32x4){0.f, 0.f, 0.f, 0.f};
    bf16x8 At[4][2], B0[2][2], B1[2][2];
    const char* cA = (const char*)g.A + (size_t)cur.pm * tstep; const char* cB = (const char*)g.Bt + (size_t)cur.pn * tstep;
    S.a_ready(cur);
    if constexpr (SP2) {
        PG8_STAGE(PG8_SB(0, 0), cB, voffB); PG8_STAGE(PG8_SB(0, 1), cB + hstep, voffB); PG8_STAGE(PG8_SA(0, 0), cA, voffA); PG8_STAGE(PG8_SA(0, 1), cA + hstep, voffA);
        if (wr == 1) PG8_BAR;
        PG8_WAIT_V(2); PG8_BAR;
        PG8_STAGE(PG8_SB(1, 0), cB + kstep, voffB); PG8_STAGE(PG8_SA(1, 0), cA + kstep, voffA); PG8_STAGE(PG8_SB(1, 1), cB + hstep + kstep, voffB);
        PG8_WAIT_V(6); PG8_BAR;
    } else {
        PG8_STAGE(PG8_SB(0, 0), cB, voffB); PG8_STAGE(PG8_SA(0, 0), cA, voffA); PG8_STAGE(PG8_SB(0, 1), cB + hstep, voffB); PG8_STAGE(PG8_SA(0, 1), cA + hstep, voffA);
        if (wr == 1) PG8_BAR;
        PG8_WAIT_V(4); PG8_BAR;
        PG8_STAGE(PG8_SB(1, 0), cB + kstep, voffB); PG8_STAGE(PG8_SA(1, 0), cA + kstep, voffA); PG8_STAGE(PG8_SB(1, 1), cB + hstep + kstep, voffB);
        PG8_WAIT_V(6); PG8_BAR;
    }
    for (;;) {
        const bool has_next = S.next(ui + 1, nxt);
        const char* nA = has_next ? (const char*)g.A + (size_t)nxt.pm * tstep : cA; const char* nB = has_next ? (const char*)g.Bt + (size_t)nxt.pn * tstep : cB;
        for (int t = 0; t < nt; t += 2) {
            const bool last = (t == nt - 2);
            const char* a1 = cA + (size_t)(t + 1) * kstep;
            const char* a2 = last ? nA : cA + (size_t)(t + 2) * kstep; const char* b2 = last ? nB : cB + (size_t)(t + 2) * kstep;
            const char* a3 = a2 + kstep; const char* b3 = b2 + kstep;
            if (last && has_next) S.a_ready(nxt);
            if constexpr (SP2) {
            PG8_LDB(B0, 0, 0); PG8_LDB(B1, 0, 1); PG8_SCHED; PG8_LDA(At, 0, 0); PG8_STAGE(PG8_SA(1, 1), a1 + hstep, voffA);
            PG8_WAIT_V(8); PG8_WAIT_L(0); PG8_BAR; PG8_MMA(0, 0, At, B0); PG8_MMA(0, 1, At, B1); PG8_BAR; PG8_SCHED;
            PG8_LDA(At, 0, 1); PG8_STAGE(PG8_SB(0, 0), b2, voffB); PG8_STAGE(PG8_SB(0, 1), b2 + hstep, voffB); PG8_STAGE(PG8_SA(0, 0), a2, voffA);
            PG8_WAIT_V(8); PG8_WAIT_L(0); PG8_BAR; PG8_MMA(1, 0, At, B0); PG8_MMA(1, 1, At, B1); PG8_BAR; PG8_SCHED;
            PG8_LDB(B0, 1, 0); PG8_LDB(B1, 1, 1); PG8_SCHED; PG8_LDA(At, 1, 0); PG8_STAGE(PG8_SA(0, 1), a2 + hstep, voffA);
            PG8_WAIT_V(8); PG8_WAIT_L(0); PG8_BAR; PG8_MMA(0, 0, At, B0); PG8_MMA(0, 1, At, B1); PG8_BAR; PG8_SCHED;
            PG8_LDA(At, 1, 1); PG8_STAGE(PG8_SB(1, 0), b3, voffB); PG8_STAGE(PG8_SB(1, 1), b3 + hstep, voffB); PG8_STAGE(PG8_SA(1, 0), a3, voffA);
            PG8_WAIT_V(8); PG8_WAIT_L(0); PG8_BAR; PG8_MMA(1, 0, At, B0); PG8_MMA(1, 1, At, B1); PG8_BAR; PG8_SCHED;
            } else {
            PG8_LDB(B0, 0, 0); PG8_SCHED; PG8_LDA(At, 0, 0); PG8_STAGE(PG8_SA(1, 1), a1 + hstep, voffA);
            PG8_WAIT_L(8); PG8_BAR; PG8_WAIT_L(0); PG8_MMA(0, 0, At, B0); PG8_BAR; PG8_SCHED;
            PG8_LDB(B1, 0, 1); PG8_STAGE(PG8_SB(0, 0), b2, voffB);
            PG8_BAR; PG8_WAIT_L(0); PG8_MMA(0, 1, At, B1); PG8_BAR;
            PG8_LDA(At, 0, 1); PG8_STAGE(PG8_SA(0, 0), a2, voffA);
            PG8_BAR; PG8_WAIT_L(0); PG8_MMA(1, 0, At, B0); PG8_BAR; PG8_SCHED;
            PG8_STAGE(PG8_SB(0, 1), b2 + hstep, voffB);
            PG8_WAIT_V(6); PG8_BAR; PG8_MMA(1, 1, At, B1); PG8_BAR;
            PG8_LDB(B0, 1, 0); PG8_SCHED; PG8_LDA(At, 1, 0); PG8_STAGE(PG8_SA(0, 1), a2 + hstep, voffA);
            PG8_WAIT_L(8); PG8_BAR; PG8_WAIT_L(0); PG8_MMA(0, 0, At, B0); PG8_BAR; PG8_SCHED;
            PG8_LDB(B1, 1, 1); PG8_STAGE(PG8_SB(1, 0), b3, voffB);
            PG8_BAR; PG8_WAIT_L(0); PG8_MMA(0, 1, At, B1); PG8_BAR;
            PG8_LDA(At, 1, 1); PG8_STAGE(PG8_SA(1, 0), a3, voffA);
            PG8_BAR; PG8_WAIT_L(0); PG8_MMA(1, 0, At, B0); PG8_BAR; PG8_SCHED;
            PG8_STAGE(PG8_SB(1, 1), b3 + hstep, voffB);
            PG8_WAIT_V(6); PG8_BAR; PG8_MMA(1, 1, At, B1); PG8_BAR;
            }
        }
        if constexpr (ALIGN_EPI) { if (wr == 0) PG8_BAR; }
        E(acc, cur, wr, wc, fr, fq); S.done(cur);
        if (!has_next) break;
#pragma unroll
        for (int a = 0; a < 2; ++a)
#pragma unroll
            for (int b = 0; b < 2; ++b)
#pragma unroll
                for (int m = 0; m < 4; ++m)
#pragma unroll
                    for (int n = 0; n < 2; ++n) acc[a][b][m][n] = (f32x4){0.f, 0.f, 0.f, 0.f};
        cur = nxt; cA = nA; cB = nB; ++ui;
        if constexpr (ALIGN_EPI) { if (wr == 1) PG8_BAR; }
    }
    PG8_WAIT_V(0);
    if constexpr (!ALIGN_EPI) { if (wr == 0) PG8_BAR; }
    PG8_BAR;
#undef PG8_SA
#undef PG8_SB
#undef PG8_STAGE
#undef PG8_LDA
#undef PG8_LDB
#undef PG8_MMA
#undef PG8_WAIT_V
#undef PG8_WAIT_L
#undef PG8_BAR
#undef PG8_SCHED
}

typedef const f32x4 (&AccRef)[2][2][4][2];
__device__ __forceinline__ u32x4 pack8(f32x4 a, f32x4 b) { u32x4 w; w.x = cvt_pk_bf16(a[0], a[1]); w.y = cvt_pk_bf16(a[2], a[3]); w.z = cvt_pk_bf16(b[0], b[1]); w.w = cvt_pk_bf16(b[2], b[3]); return w; }
__device__ __forceinline__ f32x4 silu4(f32x4 g) { f32x4 r;
#pragma unroll
    for (int i = 0; i < 4; ++i) r[i] = g[i] * fast_rcp(1.f + fast_exp2(-g[i] * LOG2E));
    return r; }

struct EpiFfnUp { static constexpr bool PERM = true;
    bf16_t* H;
    __device__ __forceinline__ void operator()(AccRef acc, const Unit& u, int wr, int wc, int fr, int fq) const {
        const int row0 = u.pm * BM + wr * 64 + fr, col0 = u.pn * HALF + wc * 32 + 8 * fq;
#pragma unroll
        for (int ai = 0; ai < 2; ++ai)
#pragma unroll
            for (int m = 0; m < 4; ++m) { bf16_t* p = H + (size_t)(row0 + ai * HALF + m * 16) * FF + col0;
                const f32x4 h0 = silu4(acc[ai][0][m][0]) * acc[ai][1][m][0], h1 = silu4(acc[ai][0][m][1]) * acc[ai][1][m][1];
                *(u32x4*)p = pack8(h0, h1); }
    }
};
struct EpiResid { static constexpr bool PERM = true;
    const float* xs0; const float* xs1; float* Z; float alpha, beta;
    __device__ __forceinline__ void operator()(AccRef acc, const Unit& u, int wr, int wc, int fr, int fq) const {
        const int row0 = u.pm * BM + wr * 64 + fr, col0 = u.pn * BM + wc * 32 + 8 * fq;
        const float* xs = (u.pm < MP / BM) ? xs0 : xs1 - (size_t)MP * D;
#pragma unroll
        for (int ai = 0; ai < 2; ++ai)
#pragma unroll
            for (int m = 0; m < 4; ++m) { const size_t off = (size_t)(row0 + ai * HALF + m * 16) * D + col0;
#pragma unroll
                for (int bj = 0; bj < 2; ++bj) { const f32x4 x0 = *(const f32x4*)(xs + off + bj * HALF), x1 = *(const f32x4*)(xs + off + bj * HALF + 4);
                    *(f32x4*)(Z + off + bj * HALF) = x0 * alpha + acc[ai][bj][m][0] * beta; *(f32x4*)(Z + off + bj * HALF + 4) = x1 * alpha + acc[ai][bj][m][1] * beta; } }
    }
};
struct EpiInEven { static constexpr bool PERM = true;
    float* U; bf16_t* QB; bf16_t* KB; bf16_t* VB; float* nk0; float* nk1; float* nv0; float* nv1;
    __device__ __forceinline__ void operator()(AccRef acc, const Unit& u, int wr, int wc, int fr, int fq) const {
        const int row0 = u.pm * BM + wr * 64 + fr, cin = wc * 32 + 8 * fq; const bool prompt = u.pm < MP / BM;
        if (u.pn < 2) {
            const int col0 = u.pn * BM + cin;
#pragma unroll
            for (int ai = 0; ai < 2; ++ai)
#pragma unroll
                for (int m = 0; m < 4; ++m) { float* p = U + (size_t)(row0 + ai * HALF + m * 16) * POOLW + col0;
#pragma unroll
                    for (int bj = 0; bj < 2; ++bj) { *(f32x4*)(p + bj * HALF) = acc[ai][bj][m][0]; *(f32x4*)(p + bj * HALF + 4) = acc[ai][bj][m][1]; } }
        } else if (u.pn < 8) {
            const int col0 = (u.pn - 2) * BM + cin;
#pragma unroll
            for (int ai = 0; ai < 2; ++ai)
#pragma unroll
                for (int m = 0; m < 4; ++m) { bf16_t* p = QB + (size_t)(row0 + ai * HALF + m * 16) * DAW + col0;
#pragma unroll
                    for (int bj = 0; bj < 2; ++bj) *(u32x4*)(p + bj * HALF) = pack8(acc[ai][bj][m][0] * QSCALE, acc[ai][bj][m][1] * QSCALE); }
        } else {
            const bool isk = u.pn < 14; const int col0 = (u.pn - (isk ? 8 : 14)) * BM + cin;
            float* o32 = isk ? (prompt ? nk0 : nk1 - (size_t)MP * DAW) : (prompt ? nv0 : nv1 - (size_t)MP * DAW);
            bf16_t* o16 = isk ? KB : VB;
#pragma unroll
            for (int ai = 0; ai < 2; ++ai)
#pragma unroll
                for (int m = 0; m < 4; ++m) { const size_t off = (size_t)(row0 + ai * HALF + m * 16) * DAW + col0;
#pragma unroll
                    for (int bj = 0; bj < 2; ++bj) { *(f32x4*)(o32 + off + bj * HALF) = acc[ai][bj][m][0]; *(f32x4*)(o32 + off + bj * HALF + 4) = acc[ai][bj][m][1];
                        if (prompt) *(u32x4*)(o16 + off + bj * HALF) = pack8(acc[ai][bj][m][0], acc[ai][bj][m][1]); } }
        }
    }
};
struct EpiInOdd { static constexpr bool PERM = true;
    bf16_t* Q2; bf16_t* KK; bf16_t* VV; bf16_t* GG; float* FD; const float* lbv;
    __device__ __forceinline__ void operator()(AccRef acc, const Unit& u, int wr, int wc, int fr, int fq) const {
        const int row0 = u.pm * BM + wr * 64 + fr, seg = u.pn >> 3, col0 = (u.pn & 7) * BM + wc * 32 + 8 * fq;
        if (seg == 1) {
#pragma unroll
            for (int bj = 0; bj < 2; ++bj) { const f32x4 lb0 = *(const f32x4*)(lbv + col0 + bj * HALF), lb1 = *(const f32x4*)(lbv + col0 + bj * HALF + 4);
#pragma unroll
                for (int ai = 0; ai < 2; ++ai)
#pragma unroll
                    for (int m = 0; m < 4; ++m) { const size_t off = (size_t)(row0 + ai * HALF + m * 16) * D + col0 + bj * HALF;
                        f32x4 f0, f1, k0, k1;
#pragma unroll
                        for (int i = 0; i < 4; ++i) { const float z0 = acc[ai][bj][m][0][i], z1 = acc[ai][bj][m][1][i];
                            const float e0 = fast_exp2(-z0 * LOG2E), e1 = fast_exp2(-z1 * LOG2E);
                            const float s0 = fast_rcp(1.f + e0), s1 = fast_rcp(1.f + e1);
                            f0[i] = lb0[i] + (1.f - lb0[i]) * s0; f1[i] = lb1[i] + (1.f - lb1[i]) * s1;
                            k0[i] = (1.f - lb0[i]) * (1.f - s0); k1[i] = (1.f - lb1[i]) * (1.f - s1); }
                        *(f32x4*)(FD + off) = f0; *(f32x4*)(FD + off + 4) = f1; *(u32x4*)(KK + off) = pack8(k0, k1); } }
        } else {
            bf16_t* O = Q2 + (size_t)seg * ((size_t)M * D); const bool act = seg != 2;
#pragma unroll
            for (int ai = 0; ai < 2; ++ai)
#pragma unroll
                for (int m = 0; m < 4; ++m) { bf16_t* p = O + (size_t)(row0 + ai * HALF + m * 16) * D + col0;
#pragma unroll
                    for (int bj = 0; bj < 2; ++bj) { f32x4 a0 = acc[ai][bj][m][0], a1 = acc[ai][bj][m][1]; if (act) { a0 = silu4(a0); a1 = silu4(a1); }
                        *(u32x4*)(p + bj * HALF) = pack8(a0, a1); } }
        }
    }
};
struct EpiBf16 { static constexpr bool PERM = true;
    bf16_t* O; int ldc;
    __device__ __forceinline__ void operator()(AccRef acc, const Unit& u, int wr, int wc, int fr, int fq) const {
        const int row0 = u.pm * BM + wr * 64 + fr, col0 = u.pn * BM + wc * 32 + 8 * fq;
#pragma unroll
        for (int ai = 0; ai < 2; ++ai)
#pragma unroll
            for (int m = 0; m < 4; ++m) { bf16_t* p = O + (size_t)(row0 + ai * HALF + m * 16) * ldc + col0;
#pragma unroll
                for (int bj = 0; bj < 2; ++bj) *(u32x4*)(p + bj * HALF) = pack8(acc[ai][bj][m][0], acc[ai][bj][m][1]); }
    }
};
struct EpiPle { static constexpr bool PERM = true;
    float* X; bf16_t* XB; const bf16_t* PU; float* y0; float* y1; int last;
    __device__ __forceinline__ void operator()(AccRef acc, const Unit& u, int wr, int wc, int fr, int fq) const {
        const int row0 = u.pm * BM + wr * 64 + fr, col0 = u.pn * BM + wc * 32 + 8 * fq;
        float* yo = (u.pm < MP / BM) ? y0 : y1 - (size_t)MP * D;
#pragma unroll
        for (int ai = 0; ai < 2; ++ai)
#pragma unroll
            for (int m = 0; m < 4; ++m) { const size_t off = (size_t)(row0 + ai * HALF + m * 16) * D + col0;
#pragma unroll
                for (int bj = 0; bj < 2; ++bj) { const size_t o = off + bj * HALF;
                    const f32x4 x0 = *(const f32x4*)(X + o), x1 = *(const f32x4*)(X + o + 4); const u32x4 pw = *(const u32x4*)(PU + o);
                    const f32x4 p0 = {bflo(pw.x), bfhi(pw.x), bflo(pw.y), bfhi(pw.y)}, p1 = {bflo(pw.z), bfhi(pw.z), bflo(pw.w), bfhi(pw.w)};
                    f32x4 r0, r1;
#pragma unroll
                    for (int i = 0; i < 4; ++i) { r0[i] = x0[i] + sigmoidf_(acc[ai][bj][m][0][i]) * p0[i]; r1[i] = x1[i] + sigmoidf_(acc[ai][bj][m][1][i]) * p1[i]; }
                    if (last) { *(f32x4*)(yo + o) = r0; *(f32x4*)(yo + o + 4) = r1; }
                    else { *(f32x4*)(X + o) = r0; *(f32x4*)(X + o + 4) = r1; *(u32x4*)(XB + o) = pack8(r0, r1); } } }
    }
};
}

#define XB_TMO      128
#define XB_XCNT(j)  (256  + 64 * (j))
#define XB_XSUB(j)  (1280 + 64 * (j))
#define XB_XGEN(j)  (2304 + 64 * (j))
#define XB_TOP      3328
#define XB_TOPGEN   3392
#define XCD_BAR_WORDS 3456
#define XB_SPIN_CAP (1u << 18)
__device__ __forceinline__ unsigned xb_ld(unsigned* p)              { return __hip_atomic_load(p, __ATOMIC_RELAXED, __HIP_MEMORY_SCOPE_AGENT); }
__device__ __forceinline__ unsigned xb_add(unsigned* p, unsigned v) { return __hip_atomic_fetch_add(p, v, __ATOMIC_RELAXED, __HIP_MEMORY_SCOPE_AGENT); }
__device__ __forceinline__ unsigned xb_xcc_id() { return (unsigned)__builtin_amdgcn_s_getreg((3 << 11) | 20) & 0xFu; }
#define XB_SPIN(cond, bar) do { unsigned _sp = 0; while (cond) { __builtin_amdgcn_s_sleep(1); \
    if ((++_sp & 255u) == 0u) { if (xb_ld(&(bar)[XB_TMO])) break; if (_sp > XB_SPIN_CAP) { atomicAdd(&(bar)[XB_TMO], 1u); break; } } } } while (0)
struct XcdBarrier { unsigned* bar; unsigned x; volatile LAS unsigned* st; };
__device__ __forceinline__ XcdBarrier xcd_barrier_post(unsigned* bar, volatile LAS unsigned* st) {
    XcdBarrier b; b.bar = bar; b.x = xb_xcc_id(); b.st = st;
    if (threadIdx.x == 0) (void)xb_add(&bar[XB_XCNT(b.x)], 1u);
    return b;
}
__device__ __forceinline__ void xcd_barrier_complete(unsigned* bar, unsigned x, unsigned& nloc, unsigned& nx) {
    const unsigned G = gridDim.x * gridDim.y * gridDim.z;
    unsigned sum, cnt, mine, sp = 0u;
    for (;;) {
        sum = 0u; cnt = 0u; mine = 0u;
#pragma unroll
        for (unsigned j = 0; j < 16; ++j) { const unsigned c = xb_ld(&bar[XB_XCNT(j)]); sum += c; cnt += (c > 0u) ? 1u : 0u; mine = (j == x) ? c : mine; }
        if (sum == G) break;
        __builtin_amdgcn_s_sleep(1);
        if ((++sp & 255u) == 0u) { if (xb_ld(&bar[XB_TMO])) break; if (sp > XB_SPIN_CAP) { atomicAdd(&bar[XB_TMO], 1u); break; } }
    }
    nloc = mine > 0u ? mine : 1u; nx = cnt > 0u ? cnt : 1u;
}
__device__ __forceinline__ void xcd_barrier(const XcdBarrier& b) {
    asm volatile("s_waitcnt vmcnt(0)" ::: "memory");
    __syncthreads();
    if (threadIdx.x == 0) {
        unsigned* bar = b.bar;
        __builtin_amdgcn_s_waitcnt(0);
        unsigned nloc = b.st[0], nx = b.st[1];
        if (nloc == 0u) { xcd_barrier_complete(bar, b.x, nloc, nx); b.st[0] = nloc; b.st[1] = nx; }
        const unsigned old = xb_add(&bar[XB_XSUB(b.x)], 1u);
        const unsigned gen = old / nloc;
        if (old + 1u == (gen + 1u) * nloc) {
            __builtin_amdgcn_fence(__ATOMIC_RELEASE, "agent");
            asm volatile("s_waitcnt vmcnt(0)" ::: "memory");
            const unsigned og = xb_add(&bar[XB_TOP], 1u);
            const unsigned tg = og / nx;
            if (og + 1u == (tg + 1u) * nx) xb_add(&bar[XB_TOPGEN], 1u);
            else XB_SPIN(xb_ld(&bar[XB_TOPGEN]) == tg, bar);
            __builtin_amdgcn_fence(__ATOMIC_ACQUIRE, "agent");
            xb_add(&bar[XB_XGEN(b.x)], 1u);
            asm volatile("s_waitcnt vmcnt(0)" ::: "memory");
        } else {
            XB_SPIN(xb_ld(&bar[XB_XGEN(b.x)]) == gen, bar);
            __builtin_amdgcn_fence(__ATOMIC_ACQUIRE, "agent");
            asm volatile("s_waitcnt vmcnt(0)" ::: "memory");
        }
    }
    __syncthreads();
}

struct Args { const float* in[29]; float* out; unsigned char* ws; int ph_lo, ph_hi; };
enum { I_XP = 0, I_XS, I_CK, I_CV, I_SPOOL, I_SHG, I_PP, I_PS, I_LNG, I_LNB, I_WG, I_WU, I_WD, I_WPG, I_WPU, I_WINE, I_WOUTE, I_POOLW, I_POOLS,
       I_LQ1, I_LK1, I_LQ2, I_LK2, I_DNG, I_RELB, I_WINO, I_WOUTO, I_HNG, I_LBL };
constexpr size_t O_YP = 0, O_YS = O_YP + (size_t)MP * D, O_KP = O_YS + (size_t)MS * D, O_VP = O_KP + (size_t)MP * DAW, O_KS = O_VP + (size_t)MP * DAW, O_VS = O_KS + (size_t)MS * DAW,
                 O_PLP = O_VS + (size_t)MS * DAW, O_PLS = O_PLP + (size_t)NB_P * 15 * POOLW, O_HGP = O_PLS + (size_t)NB_S * 15 * POOLW, O_HGS = O_HGP + (size_t)NB_P * HGH * 128 * 128,
                 O_END = O_HGS + (size_t)NB_S * HGH * 128 * 128;

__device__ __forceinline__ void tr_item(const float* W, int K, int N, bf16_t* WT, int k0, int n0, int drow0, LAS float* scr, int lane) {
#pragma unroll 8
    for (int i = 0; i < 32; ++i) { const int kk = 2 * i + (lane >> 5); scr[kk * 33 + (lane & 31)] = W[(size_t)(k0 + kk) * N + n0 + (lane & 31)]; }
    LDS_WAIT(); asm volatile("" ::: "memory");
    const int c = lane & 7;
#pragma unroll
    for (int j = 0; j < 4; ++j) { const int n = (lane >> 3) + 8 * j; const LAS float* s = scr + (8 * c) * 33 + n;
        u32x4 o; o.x = cvt_pk_bf16(s[0 * 33], s[1 * 33]); o.y = cvt_pk_bf16(s[2 * 33], s[3 * 33]); o.z = cvt_pk_bf16(s[4 * 33], s[5 * 33]); o.w = cvt_pk_bf16(s[6 * 33], s[7 * 33]);
        *(u32x4*)(WT + (size_t)(drow0 + n) * K + k0 + 8 * c) = o; }
    LDS_WAIT(); asm volatile("" ::: "memory");
}
__device__ __forceinline__ void tr_matrix_item(const float* W, int K, int N, bf16_t* WT, int kind, int item, LAS float* scr, int lane) {
    const int nblk = N / 32, kb = item / nblk, nb = item % nblk, n0 = 32 * nb;
    const int drow0 = kind == 0 ? n0 : (256 * (n0 >> 7) + (n0 & 127) + (kind == 2 ? 128 : 0));
    tr_item(W, K, N, WT, 64 * kb, n0, drow0, scr, lane);
}
__device__ __forceinline__ int t5_bucket(int rel) {
    const int n = rel < 0 ? -rel : rel; int b;
    if (n < 8) b = n; else { b = 8 + (n >= 12) + (n >= 16) + (n >= 23) + (n >= 32) + (n >= 46) + (n >= 64) + (n >= 91); }
    return b + (rel > 0 ? 16 : 0);
}
__device__ __forceinline__ void p0_prologue(const Args& a, LAS unsigned char* lds, int vcu, int NGW) {
    int tid = threadIdx.x; asm volatile("" : "+v"(tid)); const int lane = tid & 63, wave = __builtin_amdgcn_readfirstlane(tid >> 6);
    const int gw = vcu * 8 + wave;
    unsigned char* ws = a.ws;
    LAS float* scr = (LAS float*)(lds + wave * 16384);
    constexpr int I_GU = (D / 64) * (FF / 32), I_DN = (FF / 64) * (D / 32), I_INE = (D / 64) * (IN_EVEN / 32), I_SQ = (D / 64) * (D / 32), I_INO = (D / 64) * (IN_ODD / 32), I_PU = (PLE / 64) * (D / 32);
    constexpr int NITEMS = 4 * (2 * I_GU + I_DN) + I_INE + I_SQ + I_INO + I_SQ + 2 * I_SQ + 2 * I_PU;
    constexpr int I_FFN = 2 * I_GU + I_DN;
    for (int it = gw; it < NITEMS; it += NGW) {
        int r = it;
        if (r < 4 * I_FFN) { const int s = r / I_FFN; r -= s * I_FFN;
            bf16_t* wgu = (bf16_t*)(ws + WS_WGU) + (size_t)s * 2 * FF * D; bf16_t* wd = (bf16_t*)(ws + WS_WD) + (size_t)s * D * FF;
            if (r < I_GU) tr_matrix_item(a.in[I_WG] + (size_t)s * D * FF, D, FF, wgu, 1, r, scr, lane);
            else if (r < 2 * I_GU) tr_matrix_item(a.in[I_WU] + (size_t)s * D * FF, D, FF, wgu, 2, r - I_GU, scr, lane);
            else tr_matrix_item(a.in[I_WD] + (size_t)s * FF * D, FF, D, wd, 0, r - 2 * I_GU, scr, lane);
            continue; }
        r -= 4 * I_FFN;
        if (r < I_INE) { tr_matrix_item(a.in[I_WINE], D, IN_EVEN, (bf16_t*)(ws + WS_WINE), 0, r, scr, lane); continue; } r -= I_INE;
        if (r < I_SQ) { tr_matrix_item(a.in[I_WOUTE], D, D, (bf16_t*)(ws + WS_WOUTE), 0, r, scr, lane); continue; } r -= I_SQ;
        if (r < I_INO) { tr_matrix_item(a.in[I_WINO], D, IN_ODD, (bf16_t*)(ws + WS_WINO), 0, r, scr, lane); continue; } r -= I_INO;
        if (r < I_SQ) { tr_matrix_item(a.in[I_WOUTO], D, D, (bf16_t*)(ws + WS_WOUTO), 0, r, scr, lane); continue; } r -= I_SQ;
        if (r < I_SQ) { tr_matrix_item(a.in[I_WPG], D, D, (bf16_t*)(ws + WS_WPG), 0, r, scr, lane); continue; } r -= I_SQ;
        if (r < I_SQ) { tr_matrix_item(a.in[I_WPG] + (size_t)D * D, D, D, (bf16_t*)(ws + WS_WPG) + (size_t)D * D, 0, r, scr, lane); continue; } r -= I_SQ;
        if (r < I_PU) { tr_matrix_item(a.in[I_WPU], PLE, D, (bf16_t*)(ws + WS_WPU), 0, r, scr, lane); continue; } r -= I_PU;
        tr_matrix_item(a.in[I_WPU] + (size_t)PLE * D, PLE, D, (bf16_t*)(ws + WS_WPU) + (size_t)D * PLE, 0, r, scr, lane);
    }
    { const size_t gt = (size_t)gw * 64 + lane, GT = (size_t)NGW * 64; bf16_t* XB = (bf16_t*)(ws + WS_XB);
      for (size_t i = gt; i < (size_t)M * D / 8; i += GT) { const size_t e = i * 8; const float* src = e < (size_t)MP * D ? a.in[I_XP] + e : a.in[I_XS] + (e - (size_t)MP * D);
          const f32x4 v0 = *(const f32x4*)src, v1 = *(const f32x4*)(src + 4); *(u32x4*)(XB + e) = pg8::pack8(v0, v1); }
      bf16_t* PB = (bf16_t*)(ws + WS_PB);
      for (size_t i = gt; i < (size_t)2 * M * PLE / 8; i += GT) { const size_t e = i * 8; const int l = (int)(e / ((size_t)M * PLE)); const size_t r = e - (size_t)l * M * PLE;
          const float* src = r < (size_t)MP * PLE ? a.in[I_PP] + (size_t)l * MP * PLE + r : a.in[I_PS] + (size_t)l * MS * PLE + (r - (size_t)MP * PLE);
          const f32x4 v0 = *(const f32x4*)src, v1 = *(const f32x4*)(src + 4); *(u32x4*)(PB + e) = pg8::pack8(v0, v1); }
      float* tb = (float*)(ws + WS_TAB + TAB_BIAS);
      for (size_t i = gt; i < (size_t)NH * 256; i += GT) { const int h = (int)(i >> 8), idx = (int)(i & 255); const int rel = idx - 191;
          const float* rb = a.in[I_RELB]; tb[i] = idx < 255 ? (rb[t5_bucket(rel) * NH + h] - rb[15 * NH + h]) * LOG2E : 0.f; }
      float* lbv = (float*)(ws + WS_TAB + TAB_LB);
      for (size_t i = gt; i < (size_t)D; i += GT) { const float l0 = a.in[I_LBL][i], l1 = a.in[I_LBL][D + i]; const float mx = fmaxf(l0, l1), e0 = __expf(l0 - mx), e1 = __expf(l1 - mx); lbv[i] = e1 / (e0 + e1); }
      bf16_t* pwt = (bf16_t*)(ws + WS_TAB + TAB_PWT);
      for (size_t i = gt; i < (size_t)4 * 128 * 128; i += GT) { const int g = (int)(i >> 14), n = (int)((i >> 7) & 127), k = (int)(i & 127);
          pwt[i] = (bf16_t)(cvt_pk_bf16(a.in[I_POOLW][((size_t)g * 128 + k) * 128 + n], 0.f) & 0xffffu); }
    }
}

__device__ __forceinline__ void ln_phase(float* X, bf16_t* XB, const float* g, const float* b, int vcu, int NGW) {
    int tid = threadIdx.x; asm volatile("" : "+v"(tid)); const int lane = tid & 63, wave = __builtin_amdgcn_readfirstlane(tid >> 6);
    const int gw = vcu * 8 + wave;
    f32x4 gv[8], bv[8];
#pragma unroll
    for (int j = 0; j < 8; ++j) { gv[j] = *(const f32x4*)(g + (j * 64 + lane) * 4); bv[j] = *(const f32x4*)(b + (j * 64 + lane) * 4); }
    for (int row = gw; row < M; row += NGW) {
        float* xr = X + (size_t)row * D; f32x4 v[8]; float s = 0.f;
#pragma unroll
        for (int j = 0; j < 8; ++j) { v[j] = *(const f32x4*)(xr + (j * 64 + lane) * 4); s += (v[j][0] + v[j][1]) + (v[j][2] + v[j][3]); }
        const float mean = wave_sum(s) * (1.f / D); float s2 = 0.f;
#pragma unroll
        for (int j = 0; j < 8; ++j) { v[j] = v[j] - mean; s2 += (v[j][0] * v[j][0] + v[j][1] * v[j][1]) + (v[j][2] * v[j][2] + v[j][3] * v[j][3]); }
        const float rstd = 1.f / sqrtf(wave_sum(s2) * (1.f / D) + LN_EPS);
        bf16_t* xb = XB + (size_t)row * D;
#pragma unroll
        for (int j = 0; j < 8; ++j) { const f32x4 o = v[j] * rstd * gv[j] + bv[j]; *(f32x4*)(xr + (j * 64 + lane) * 4) = o;
            u32x2 w; w.x = cvt_pk_bf16(o[0], o[1]); w.y = cvt_pk_bf16(o[2], o[3]); *(u32x2*)(xb + (j * 64 + lane) * 4) = w; }
    }
}

#define KSWZ(row, colB) ((row) * 256 + ((colB) ^ (((row) & 7) << 4)))
__device__ __forceinline__ int crow(int r, int hi) { return (r & 3) + 8 * (r >> 2) + 4 * hi; }
__device__ __forceinline__ void pool_phase(const Args& a, LAS unsigned char* lds) {
    int tid = threadIdx.x; asm volatile("" : "+v"(tid)); const int lane = tid & 63, wave = __builtin_amdgcn_readfirstlane(tid >> 6);
    const float* U = (const float*)(a.ws + WS_U); bf16_t* MIX = (bf16_t*)(a.ws + WS_MIX); const bf16_t* pwt = (const bf16_t*)(a.ws + WS_TAB + TAB_PWT);
    LAS float* full = (LAS float*)lds;
    LAS unsigned char* pa = lds + 40960;
    const int r32 = lane & 31, hi = lane >> 5;
    for (int unit = blockIdx.x; unit < (M / 64) * 4; unit += gridDim.x) {
        const int rb = unit >> 2, g = unit & 3, r0 = rb * 64; const bool smp = r0 >= MP;
        const int t0 = smp ? 0 : (r0 & (SEQ - 1)); const int bs = smp ? (r0 - MP) / DSEQ : 0;
        for (int p = tid; p < 79 * 32; p += 512) { const int i = p >> 5, c4 = (p & 31) * 4; const int t = t0 - 15 + i; f32x4 v = {0.f, 0.f, 0.f, 0.f};
            if (t >= 0) v = *(const f32x4*)(U + (size_t)(r0 - 15 + i) * POOLW + g * 128 + c4);
            else if (smp) v = *(const f32x4*)(a.in[I_SPOOL] + ((size_t)bs * 15 + (15 + t)) * POOLW + g * 128 + c4);
            *(LAS f32x4*)(full + i * 128 + c4) = v; }
        __syncthreads();
        { const int c = tid & 127, rq = tid >> 7, w = 2 << g;
          for (int tt = rq * 16; tt < rq * 16 + 16; ++tt) { float s = 0.f;
              for (int j = 0; j < w; ++j) s += full[(15 + tt - j) * 128 + c];
              const int cnt = smp ? w : ((t0 + tt + 1) < w ? (t0 + tt + 1) : w);
              const float pv = s / (float)cnt - full[(15 + tt) * 128 + c];
              *(LAS bf16_t*)(pa + KSWZ(tt, c * 2)) = (bf16_t)(cvt_pk_bf16(pv, 0.f) & 0xffffu); } }
        __syncthreads();
        { const int rt = wave >> 2, ct = wave & 3; f32x16 acc = {};
#pragma unroll
          for (int s = 0; s < 8; ++s) { const bf16x8 af = *(const LAS bf16x8*)(pa + KSWZ(32 * rt + r32, (16 * s + 8 * hi) * 2));
              const bf16x8 bfr = *(const bf16x8*)(pwt + ((size_t)g * 128 + 32 * ct + r32) * 128 + 16 * s + 8 * hi);
              acc = __builtin_amdgcn_mfma_f32_32x32x16_bf16(af, bfr, acc, 0, 0, 0); }
          const int n = g * 128 + 32 * ct + r32; const float sc = a.in[I_POOLS][n];
#pragma unroll
          for (int r = 0; r < 16; ++r) { const int row = r0 + 32 * rt + crow(r, hi); MIX[(size_t)row * D + n] = (bf16_t)(cvt_pk_bf16(acc[r] * sc, 0.f) & 0xffffu); } }
        __syncthreads();
    }
    { float* op = a.out + O_PLP; float* os = a.out + O_PLS;
      for (int i = blockIdx.x * 512 + tid; i < NB_P * 15 * POOLW; i += gridDim.x * 512) { const int c = i & 511, j = (i >> 9) % 15, b = i / (15 * POOLW); op[i] = U[((size_t)b * SEQ + SEQ - 15 + j) * POOLW + c]; }
      for (int i = blockIdx.x * 512 + tid; i < NB_S * 15 * POOLW; i += gridDim.x * 512) { const int c = i & 511, j = (i >> 9) % 15, b = i / (15 * POOLW); os[i] = U[((size_t)MP + (size_t)b * DSEQ + DSEQ - 15 + j) * POOLW + c]; } }
}

namespace att {
__device__ __forceinline__ int v_st(int k, int c) { const int kk = (k & ~0xC) | ((k & 4) << 1) | ((k & 8) >> 1); return ((kk >> 3) * 4 + (c >> 5)) * 512 + ((kk & 7) * 32 + (c & 31)) * 2; }
__device__ __forceinline__ int v_rd_base(int lane) { return ((lane & 3) << 3) | (((lane >> 2) & 3) << 6) | (((lane >> 4) & 1) << 5) | (((lane >> 5) & 1) << 8); }
constexpr int v_rd_off(int d0, int ks, int half) { return d0 * 512 + ks * 4096 + half * 2048; }
template <int OFF> __device__ __forceinline__ s16x4 tr_read(unsigned vb) { s16x4 r; asm volatile("ds_read_b64_tr_b16 %0, %1 offset:%2" : "=&v"(r) : "v"(vb), "i"(OFF) : "memory"); return r; }
template <int D0, int H> __device__ __forceinline__ void pv_half(f32x16& od, unsigned vb, bf16x8 pa0, bf16x8 pa1) {
    const s16x4 l0 = tr_read<v_rd_off(D0, 2 * H, 0)>(vb), h0 = tr_read<v_rd_off(D0, 2 * H, 1)>(vb), l1 = tr_read<v_rd_off(D0, 2 * H + 1, 0)>(vb), h1 = tr_read<v_rd_off(D0, 2 * H + 1, 1)>(vb);
    asm volatile("s_waitcnt lgkmcnt(0)" ::: "memory"); __builtin_amdgcn_sched_barrier(0);
#define PK(L, H_) (bf16x8){L[0], L[1], L[2], L[3], H_[0], H_[1], H_[2], H_[3]}
    od = __builtin_amdgcn_mfma_f32_32x32x16_bf16(pa0, PK(l0, h0), od, 0, 0, 0);
    od = __builtin_amdgcn_mfma_f32_32x32x16_bf16(pa1, PK(l1, h1), od, 0, 0, 0);
#undef PK
}
__device__ __forceinline__ u32x4 ld_bf8(const bf16_t* p) { return *(const u32x4*)p; }
__device__ __forceinline__ u32x4 ld_f8(const float* p) { const f32x4 a = *(const f32x4*)p, b = *(const f32x4*)(p + 4); return pg8::pack8(a, b); }

__device__ __forceinline__ void scores_h(f32x16& a, f32x16& b, const LAS unsigned char* Ks, int krow, const bf16x8* qr, int hi, bool near, const LAS float* tb, int idx) {
    a = (f32x16){}; b = (f32x16){};
#pragma unroll
    for (int d0 = 0; d0 < 4; ++d0) { const bf16x8 k0 = *(const LAS bf16x8*)(Ks + KSWZ(krow, (d0 * 16 + hi * 8) * 2)); a = __builtin_amdgcn_mfma_f32_32x32x16_bf16(k0, qr[d0], a, 0, 0, 0); }
#pragma unroll
    for (int d0 = 4; d0 < 8; ++d0) { const bf16x8 k0 = *(const LAS bf16x8*)(Ks + KSWZ(krow, (d0 * 16 + hi * 8) * 2)); b = __builtin_amdgcn_mfma_f32_32x32x16_bf16(k0, qr[d0], b, 0, 0, 0); }
    if (near) {
#pragma unroll
        for (int r = 0; r < 16; ++r) { const float v0 = tb[idx + (r & 3) + 8 * (r >> 2)]; a[r] += v0; b[r] += v0; }
    }
}
__device__ __forceinline__ float xhalf_max(float v) { auto rr = __builtin_amdgcn_permlane32_swap(__float_as_uint(v), __float_as_uint(v), false, false); return fmaxf(__uint_as_float(rr[0]), __uint_as_float(rr[1])); }
__device__ __forceinline__ float xhalf_sum(float v) { auto rr = __builtin_amdgcn_permlane32_swap(__float_as_uint(v), __float_as_uint(v), false, false); return __uint_as_float(rr[0]) + __uint_as_float(rr[1]); }
__device__ __forceinline__ void stat_update(float& m, float& l, const f32x16& x) {
    float mx = x[0];
#pragma unroll
    for (int r = 1; r < 16; ++r) mx = fmaxf(mx, x[r]);
    mx = xhalf_max(mx); const float mn = fmaxf(m, mx); float s = 0.f;
#pragma unroll
    for (int r = 0; r < 16; ++r) s += fast_exp2(x[r] - mn);
    l = l * fast_exp2(m - mn) + s; m = mn;
}
#define PK4(P, BASE, OUT) do { unsigned a0_ = cvt_pk_bf16(P[BASE + 0], P[BASE + 1]), a1_ = cvt_pk_bf16(P[BASE + 2], P[BASE + 3]);   \
    unsigned b0_ = cvt_pk_bf16(P[BASE + 4], P[BASE + 5]), b1_ = cvt_pk_bf16(P[BASE + 6], P[BASE + 7]);                              \
    auto r0_ = __builtin_amdgcn_permlane32_swap(a0_, b0_, false, false); auto r1_ = __builtin_amdgcn_permlane32_swap(a1_, b1_, false, false); \
    u32x4 w_ = {r0_[0], r1_[0], r0_[1], r1_[1]}; OUT = __builtin_bit_cast(bf16x8, w_); } while (0)

template <bool SAMPLE>
__device__ __forceinline__ void attn_unit(const Args& a, LAS unsigned char* lds, int uidx, int tid_in, int wave, float lam) {
    int tid = tid_in; asm volatile("" : "+v"(tid));
    const int lane = tid & 63, r32 = lane & 31, hi = lane >> 5;
    const bf16_t* QB = (const bf16_t*)(a.ws + WS_QB); const bf16_t* KB = (const bf16_t*)(a.ws + WS_KB); const bf16_t* VB = (const bf16_t*)(a.ws + WS_VB); bf16_t* MIX = (bf16_t*)(a.ws + WS_MIX);
    LAS float* tb = (LAS float*)(lds + LDS_ATAB);
    int b, h, qb = 0, h0 = 0;
    if (SAMPLE) { b = uidx / 3; h0 = (uidx % 3) * 4; h = h0 + (wave >> 1); }
    else { const int k = uidx; qb = 7 - k / (NB_P * NH); const int bh = k % (NB_P * NH); b = bh / NH; h = bh % NH; }
    const int nsteps = SAMPLE ? 33 : qb + 1;
    const int cw = SAMPLE ? 32 : 4 * qb + (wave >> 1);
    const size_t qrow = SAMPLE ? (size_t)MP + (size_t)b * DSEQ + 32 * (wave & 1) : (size_t)b * SEQ + qb * 256 + 32 * wave;
    if (SAMPLE) { for (int i = tid; i < 1024; i += 512) tb[i] = ((const float*)(a.ws + WS_TAB + TAB_BIAS))[(h0 + (i >> 8)) * 256 + (i & 255)]; }
    else { if (tid < 256) tb[tid] = ((const float*)(a.ws + WS_TAB + TAB_BIAS))[h * 256 + tid]; }
    const LAS float* tbw = tb + (SAMPLE ? 256 * (wave >> 1) : 0);
    bf16x8 qr[8];
    { const bf16_t* qp = QB + (qrow + r32) * DAW + h * HD + hi * 8;
#pragma unroll
      for (int d0 = 0; d0 < 8; ++d0) qr[d0] = *(const bf16x8*)(qp + d0 * 16); }
    const int sr = tid >> 4, sc = (tid & 15) * 8;
    const int kst0 = KSWZ(sr, sc * 2), kst1 = KSWZ(32 + sr, sc * 2), vst0 = v_st(sr, sc), vst1 = v_st(32 + sr, sc);
    float m1 = -1e30f, l1 = 0.f, m2 = -1e30f, l2 = 0.f;
    const int jlo = SAMPLE ? (wave >> 1) : 0, jhi = SAMPLE ? (wave >> 1) : 3;
    const int idxw = -64 * cw - 32 * (wave & 1) - r32 + 191 + 4 * hi;
#define ATT_STAGE(WITHV) do { _Pragma("unroll 1") for (int j = 0; j < 4; ++j) { LAS unsigned char* Ks = lds + j * 32768; LAS unsigned char* Vs = Ks + 16384;                    \
        if (SAMPLE) { const int hh = h0 + j; const float* kp; const float* vp; size_t rs;                                                                                  \
            if (s < 32) { const size_t o_ = (((size_t)b * PAST + 64 * s + sr) * NH + hh) * HD + sc; kp = a.in[I_CK] + o_; vp = a.in[I_CV] + o_; rs = (size_t)32 * NH * HD; }        \
            else { const size_t o_ = ((size_t)b * DSEQ + sr) * DAW + hh * HD + sc; kp = a.out + O_KS + o_; vp = a.out + O_VS + o_; rs = (size_t)32 * DAW; }                      \
            { const u32x4 k0 = ld_f8(kp), k1 = ld_f8(kp + rs); *(LAS u32x4*)(Ks + kst0) = k0; *(LAS u32x4*)(Ks + kst1) = k1; }                                             \
            if (WITHV) { const u32x4 v0 = ld_f8(vp), v1 = ld_f8(vp + rs); *(LAS u32x4*)(Vs + vst0) = v0; *(LAS u32x4*)(Vs + vst1) = v1; }                                    \
        } else { const size_t o_ = ((size_t)b * SEQ + 64 * (4 * s + j) + sr) * DAW + h * HD + sc;                                                                        \
            { const u32x4 k0 = ld_bf8(KB + o_), k1 = ld_bf8(KB + o_ + (size_t)32 * DAW); *(LAS u32x4*)(Ks + kst0) = k0; *(LAS u32x4*)(Ks + kst1) = k1; }                   \
            if (WITHV) { const u32x4 v0 = ld_bf8(VB + o_), v1 = ld_bf8(VB + o_ + (size_t)32 * DAW); *(LAS u32x4*)(Vs + vst0) = v0; *(LAS u32x4*)(Vs + vst1) = v1; } } } } while (0)
#pragma unroll 1
    for (int s = 0; s < nsteps; ++s) {
        ATT_STAGE(false);
        __syncthreads();
#pragma unroll 1
        for (int j = jlo; j <= jhi; ++j) { const int t = SAMPLE ? s : 4 * s + j;
            if (t > cw) break;
            const bool near = t >= cw - 2; const LAS unsigned char* Ks = lds + j * 32768; const int idx = near ? idxw + 64 * t : 0;
#pragma unroll
            for (int hf = 0; hf < 2; ++hf) { f32x16 x, y; scores_h(x, y, Ks, 32 * hf + r32, qr, hi, near, tbw, idx + 32 * hf); stat_update(m1, l1, x); stat_update(m2, l2, y); } }
        __syncthreads();
    }
    const float il1 = fast_rcp(xhalf_sum(l1)), cl2 = lam * fast_rcp(xhalf_sum(l2));
    f32x16 o[4] = {};
#pragma unroll 1
    for (int s = 0; s < nsteps; ++s) {
        ATT_STAGE(true);
        __syncthreads();
#pragma unroll 1
        for (int j = jlo; j <= jhi; ++j) { const int t = SAMPLE ? s : 4 * s + j;
            if (t > cw) break;
            const LAS unsigned char* Ks = lds + j * 32768; const bool near = t >= cw - 2; const int idx = near ? idxw + 64 * t : 0;
            const unsigned vb = (unsigned)(size_t)(Ks + 16384) + (unsigned)v_rd_base(lane);
            { f32x16 x, y; scores_h(x, y, Ks, r32, qr, hi, near, tbw, idx);
#pragma unroll
              for (int r = 0; r < 16; ++r) x[r] = fast_exp2(x[r] - m1) * il1 - fast_exp2(y[r] - m2) * cl2;
              bf16x8 pa0, pa1; PK4(x, 0, pa0); PK4(x, 8, pa1);
              pv_half<0, 0>(o[0], vb, pa0, pa1); pv_half<1, 0>(o[1], vb, pa0, pa1); pv_half<2, 0>(o[2], vb, pa0, pa1); pv_half<3, 0>(o[3], vb, pa0, pa1); }
            { f32x16 x, y; scores_h(x, y, Ks, 32 + r32, qr, hi, near, tbw, idx + 32);
#pragma unroll
              for (int r = 0; r < 16; ++r) x[r] = fast_exp2(x[r] - m1) * il1 - fast_exp2(y[r] - m2) * cl2;
              bf16x8 pa0, pa1; PK4(x, 0, pa0); PK4(x, 8, pa1);
              pv_half<0, 1>(o[0], vb, pa0, pa1); pv_half<1, 1>(o[1], vb, pa0, pa1); pv_half<2, 1>(o[2], vb, pa0, pa1); pv_half<3, 1>(o[3], vb, pa0, pa1); } }
        __syncthreads();
    }
#undef ATT_STAGE
    float ss[16];
#pragma unroll
    for (int r = 0; r < 16; ++r) { float v = o[0][r] * o[0][r] + o[1][r] * o[1][r] + o[2][r] * o[2][r] + o[3][r] * o[3][r];
#pragma unroll
        for (int sft = 1; sft < 32; sft <<= 1) v += __shfl_xor(v, sft);
        ss[r] = (1.f - LAM_INIT) / sqrtf(v * (1.f / HD) + LN_EPS); }
    float gq[4];
#pragma unroll
    for (int d0 = 0; d0 < 4; ++d0) gq[d0] = a.in[I_DNG][32 * d0 + r32];
#pragma unroll
    for (int r = 0; r < 16; ++r) { bf16_t* op = MIX + (qrow + crow(r, hi)) * D + POOLW + h * HD + r32;
#pragma unroll
        for (int d0 = 0; d0 < 4; ++d0) op[32 * d0] = (bf16_t)(cvt_pk_bf16(o[d0][r] * ss[r] * gq[d0], 0.f) & 0xffffu); }
}
constexpr int N_SAMPLE_UNITS = NB_S * 3, N_PROMPT_UNITS = NB_P * NH * 8, N_UNITS = N_SAMPLE_UNITS + N_PROMPT_UNITS;
}

__device__ __forceinline__ void attn_phase(const Args& a, LAS unsigned char* lds) {
    int tid = threadIdx.x; asm volatile("" : "+v"(tid)); const int lane = tid & 63, wave = __builtin_amdgcn_readfirstlane(tid >> 6);
    float lam;
    { const float p1 = a.in[I_LQ1][lane] * a.in[I_LK1][lane], p2 = a.in[I_LQ2][lane] * a.in[I_LK2][lane]; lam = __expf(wave_sum(p1)) - __expf(wave_sum(p2)) + LAM_INIT; }
    unsigned* qhead = (unsigned*)(a.ws + WS_CTL) + CW_QATT;
    volatile LAS unsigned* bc = (volatile LAS unsigned*)(lds + LDS_MISC + 64);
    for (;;) {
        if (tid == 0) *bc = atomicAdd(qhead, 1u);
        __syncthreads();
        const int u = (int)*bc;
        __syncthreads();
        if (u >= att::N_UNITS) break;
        if (u < att::N_SAMPLE_UNITS) att::attn_unit<true>(a, lds, u, tid, wave, lam);
        else att::attn_unit<false>(a, lds, u - att::N_SAMPLE_UNITS, tid, wave, lam);
    }
}

__device__ __forceinline__ void hgrn_phase(const Args& a, LAS unsigned char* lds) {
    int tid = threadIdx.x; asm volatile("" : "+v"(tid)); const int lane = tid & 63, wave = __builtin_amdgcn_readfirstlane(tid >> 6);
    const bf16_t* Q2 = (const bf16_t*)(a.ws + WS_Q2); const bf16_t* KK = (const bf16_t*)(a.ws + WS_KK); const bf16_t* VV = (const bf16_t*)(a.ws + WS_VV); const bf16_t* GG = (const bf16_t*)(a.ws + WS_GG);
    const float* FD = (const float*)(a.ws + WS_FD); bf16_t* MIX = (bf16_t*)(a.ws + WS_MIX);
    LAS float* qs = (LAS float*)lds; LAS float* ks = qs + 2048; LAS float* fs = ks + 2048; LAS float* vs = fs + 2048; LAS float* red = vs + 2048;
    const int e = tid & 127, dq = tid >> 7;
    for (int unit = blockIdx.x; unit < NB_P * HGH + NB_S * HGH; unit += gridDim.x) {
        const bool smp = unit >= NB_P * HGH; const int bh = smp ? unit - NB_P * HGH : unit; const int b = bh >> 4, h = bh & 15;
        const int T = smp ? DSEQ : SEQ; const size_t row0 = smp ? (size_t)MP + (size_t)b * DSEQ : (size_t)b * SEQ;
        float S[32];
        if (smp) { const float* sp = a.in[I_SHG] + (((size_t)b * HGH + h) * 128 + 32 * dq) * 128 + e;
#pragma unroll
            for (int d = 0; d < 32; ++d) S[d] = sp[(size_t)d * 128]; }
        else {
#pragma unroll
            for (int d = 0; d < 32; ++d) S[d] = 0.f; }
        for (int t0 = 0; t0 < T; t0 += 16) {
            { const int tt = tid >> 5, c4 = (tid & 31) * 4; const size_t off = (row0 + t0 + tt) * D + h * 128 + c4;
              const u32x2 qw = *(const u32x2*)(Q2 + off), kw = *(const u32x2*)(KK + off), vw = *(const u32x2*)(VV + off); const f32x4 fv = *(const f32x4*)(FD + off);
              *(LAS f32x4*)(qs + tt * 128 + c4) = (f32x4){bflo(qw.x), bfhi(qw.x), bflo(qw.y), bfhi(qw.y)};
              *(LAS f32x4*)(ks + tt * 128 + c4) = (f32x4){bflo(kw.x), bfhi(kw.x), bflo(kw.y), bfhi(kw.y)};
              *(LAS f32x4*)(vs + tt * 128 + c4) = (f32x4){bflo(vw.x), bfhi(vw.x), bflo(vw.y), bfhi(vw.y)};
              *(LAS f32x4*)(fs + tt * 128 + c4) = fv; }
            __syncthreads();
#pragma unroll 2
            for (int tt = 0; tt < 16; ++tt) { const float v = vs[tt * 128 + e]; float acc = 0.f;
#pragma unroll
                for (int dd = 0; dd < 32; dd += 4) { const f32x4 f4 = *(const LAS f32x4*)(fs + tt * 128 + 32 * dq + dd), k4 = *(const LAS f32x4*)(ks + tt * 128 + 32 * dq + dd), q4 = *(const LAS f32x4*)(qs + tt * 128 + 32 * dq + dd);
#pragma unroll
                    for (int i = 0; i < 4; ++i) { S[dd + i] = f4[i] * S[dd + i] + k4[i] * v; acc += q4[i] * S[dd + i]; } }
                red[(tt * 4 + dq) * 128 + e] = acc; }
            __syncthreads();
            { const int tt = tid >> 5, c4 = (tid & 31) * 4; f32x4 ov = *(const LAS f32x4*)(red + (tt * 4 + 0) * 128 + c4);
#pragma unroll
              for (int q = 1; q < 4; ++q) ov += *(const LAS f32x4*)(red + (tt * 4 + q) * 128 + c4);
              float ssq = (ov[0] * ov[0] + ov[1] * ov[1]) + (ov[2] * ov[2] + ov[3] * ov[3]);
#pragma unroll
              for (int sft = 1; sft < 32; sft <<= 1) ssq += __shfl_xor(ssq, sft);
              const float rstd = 1.f / sqrtf(ssq * (1.f / 128) + LN_EPS);
              const size_t off = (row0 + t0 + tt) * D + h * 128 + c4; const u32x2 gw = *(const u32x2*)(GG + off); const f32x4 gn = *(const f32x4*)(a.in[I_HNG] + c4);
              const f32x4 gt = {bflo(gw.x), bfhi(gw.x), bflo(gw.y), bfhi(gw.y)}; const f32x4 r = ov * rstd * gn * gt;
              u32x2 w; w.x = cvt_pk_bf16(r[0], r[1]); w.y = cvt_pk_bf16(r[2], r[3]); *(u32x2*)(MIX + off) = w; }
        }
        { float* sp = a.out + (smp ? O_HGS : O_HGP) + (((size_t)b * HGH + h) * 128 + 32 * dq) * 128 + e;
#pragma unroll
          for (int d = 0; d < 32; ++d) sp[(size_t)d * 128] = S[d]; }
        __syncthreads();
    }
}

constexpr int N_PHASES = 25;
__global__ void __launch_bounds__(512, 2) fwd(Args a) {
    extern __shared__ __attribute__((aligned(16))) unsigned char lds_raw[];
    LAS unsigned char* lds = (LAS unsigned char*)lds_raw;
    const int tid = threadIdx.x;
    const int G = gridDim.x; const int vcu = (G % 8 == 0) ? ((int)blockIdx.x % 8) * (G / 8) + (int)blockIdx.x / 8 : (int)blockIdx.x;
    const int NGW = G * 8;
    unsigned char* ws = a.ws;
    for (int u = tid; u < 64; u += 512) ((LAS unsigned*)(lds + LDS_MISC))[u] = 0u;
    __syncthreads();
#if MK_ONE_LAUNCH
    XcdBarrier bar = xcd_barrier_post((unsigned*)(ws + WS_CTL) + CW_BAR, (volatile LAS unsigned*)(lds + LDS_MISC + 32));
#define GRID_BAR() xcd_barrier(bar)
#else
#define GRID_BAR() do {} while (0)
#endif
    const int lo = a.ph_lo, hi = a.ph_hi;
#ifndef PHASE_MASK
#define PHASE_MASK 0xFFFF
#endif
#define KIND(n) (((PHASE_MASK) >> (n)) & 1)
#define IN(k) (lo <= (k) && (k) < hi)
#define SEAM(k) do { if (IN(k) && IN((k) + 1)) GRID_BAR(); } while (0)
    float* X = (float*)(ws + WS_X); bf16_t* XB = (bf16_t*)(ws + WS_XB); bf16_t* H = (bf16_t*)(ws + WS_H); bf16_t* MIX = (bf16_t*)(ws + WS_MIX); bf16_t* PU = (bf16_t*)(ws + WS_PU);

    if (KIND(0) && IN(0)) { p0_prologue(a, lds, vcu, NGW); } SEAM(0);

#pragma unroll
    for (int l = 0; l < 2; ++l) {
        const int pb = 1 + 12 * l;
        const float* lng = a.in[I_LNG] + (size_t)l * 3 * D; const float* lnb = a.in[I_LNB] + (size_t)l * 3 * D;
#pragma unroll
        for (int j = 0; j < 2; ++j) {
            const int p = pb + 7 * j; const int s = 2 * l + j;
            if (KIND(1) && IN(p)) { pg8::Gemm g{(l == 1 && j == 0) ? MIX : XB  , (const bf16_t*)(ws + WS_WGU) + (size_t)s * 2 * FF * D, M, 2 * FF, D}; pg8::StaticOrder S; S.init(M, 2 * FF, G, (int)blockIdx.x);
                pg8::EpiFfnUp E{H}; pg8::gemm_phase<pg8::EpiFfnUp, pg8::StaticOrder, true, true>(lds, g, S, E); }
            SEAM(p);
            if (KIND(2) && IN(p + 1)) { pg8::Gemm g{H, (const bf16_t*)(ws + WS_WD) + (size_t)s * D * FF, M, D, FF}; pg8::StaticOrder S; S.init(M, D, G, (int)blockIdx.x);
                const bool first = (l == 0 && j == 0);
                pg8::EpiResid E{first ? a.in[I_XP] : X, first ? a.in[I_XS] : X + (size_t)MP * D, X, ALPHA, 0.5f};
                pg8::gemm_phase<pg8::EpiResid, pg8::StaticOrder, true, true>(lds, g, S, E); }
            SEAM(p + 1);
            if (KIND(3) && IN(p + 2)) ln_phase(X, XB, lng + (size_t)(2 * j) * D, lnb + (size_t)(2 * j) * D, vcu, NGW);
            SEAM(p + 2);
            if (j == 0) {
                if (l == 0) {
                    if (KIND(4) && IN(pb + 3)) { pg8::Gemm g{XB, (const bf16_t*)(ws + WS_WINE), M, IN_EVEN, D}; pg8::StaticOrder S; S.init(M, IN_EVEN, G, (int)blockIdx.x);
                        pg8::EpiInEven E{(float*)(ws + WS_U), (bf16_t*)(ws + WS_QB), (bf16_t*)(ws + WS_KB), (bf16_t*)(ws + WS_VB), a.out + O_KP, a.out + O_KS, a.out + O_VP, a.out + O_VS};
                        pg8::gemm_phase<pg8::EpiInEven, pg8::StaticOrder, true, true>(lds, g, S, E); }
                    SEAM(pb + 3);
                    if (IN(pb + 4)) { if (KIND(5)) attn_phase(a, lds); if (KIND(6)) pool_phase(a, lds); }
                    SEAM(pb + 4);
                } else {
                    if (KIND(7) && IN(pb + 3)) { pg8::Gemm g{XB, (const bf16_t*)(ws + WS_WINO), M, IN_ODD, D}; pg8::StaticOrder S; S.init(M, IN_ODD, G, (int)blockIdx.x);
                        pg8::EpiInOdd E{(bf16_t*)(ws + WS_Q2), (bf16_t*)(ws + WS_KK), (bf16_t*)(ws + WS_VV), (bf16_t*)(ws + WS_GG), (float*)(ws + WS_FD), (const float*)(ws + WS_TAB + TAB_LB)};
                        pg8::gemm_phase<pg8::EpiInOdd, pg8::StaticOrder, true, true>(lds, g, S, E); }
                    SEAM(pb + 3);
                    if (KIND(8) && IN(pb + 4)) hgrn_phase(a, lds);
                    SEAM(pb + 4);
                }
                if (KIND(9) && IN(pb + 5)) { pg8::Gemm g{MIX, (const bf16_t*)(ws + (l == 0 ? WS_WOUTE : WS_WOUTO)), M, D, D}; pg8::StaticOrder S; S.init(M, D, G, (int)blockIdx.x);
                    pg8::EpiResid E{X, X + (size_t)MP * D, X, ALPHA, 1.0f};
                    pg8::gemm_phase<pg8::EpiResid, pg8::StaticOrder, true, true>(lds, g, S, E); }
                SEAM(pb + 5);
                if (KIND(3) && IN(pb + 6)) ln_phase(X, XB, lng + (size_t)1 * D, lnb + (size_t)1 * D, vcu, NGW);
                SEAM(pb + 6);
            }
        }
        if (KIND(10) && IN(pb + 10)) { pg8::Gemm g{(const bf16_t*)(ws + WS_PB) + (size_t)l * M * PLE, (const bf16_t*)(ws + WS_WPU) + (size_t)l * D * PLE, M, D, PLE}; pg8::StaticOrder S; S.init(M, D, G, (int)blockIdx.x);
            pg8::EpiBf16 E{PU, D}; pg8::gemm_phase<pg8::EpiBf16, pg8::StaticOrder, true, true>(lds, g, S, E); }
        SEAM(pb + 10);
        if (KIND(11) && IN(pb + 11)) { pg8::Gemm g{XB, (const bf16_t*)(ws + WS_WPG) + (size_t)l * D * D, M, D, D}; pg8::StaticOrder S; S.init(M, D, G, (int)blockIdx.x);
            pg8::EpiPle E{X, MIX, PU, a.out + O_YP, a.out + O_YS, l == 1 ? 1 : 0};
            pg8::gemm_phase<pg8::EpiPle, pg8::StaticOrder, true, true>(lds, g, S, E); }
        SEAM(pb + 11);
    }
#undef IN
#undef SEAM
}

extern "C" void kernel_launch(void* const* d_in, const int* in_sizes, int n_in, void* d_out, int out_size, void* d_ws, size_t ws_size, hipStream_t stream) {
    static int grid = 0;
    if (grid == 0) {
        if (n_in != 29 || (size_t)out_size != O_END || ws_size < WS_END) { fprintf(stderr, "kernel_launch: shape mismatch: n_in %d out %d (want %zu) ws %zu (want >= %zu)\n", n_in, out_size, (size_t)O_END, ws_size, (size_t)WS_END); grid = -1; return; }
        int dev = 0, cus = 0, per_cu = 0;
        if (hipGetDevice(&dev) != hipSuccess || hipDeviceGetAttribute(&cus, hipDeviceAttributeMultiprocessorCount, dev) != hipSuccess) { fprintf(stderr, "kernel_launch: device query failed\n"); grid = -1; return; }
        if (hipFuncSetAttribute((const void*)fwd, hipFuncAttributeMaxDynamicSharedMemorySize, LDS_BYTES) != hipSuccess) { fprintf(stderr, "kernel_launch: hipFuncSetAttribute failed\n"); grid = -1; return; }
        if (hipOccupancyMaxActiveBlocksPerMultiprocessor(&per_cu, (const void*)fwd, 512, LDS_BYTES) != hipSuccess || per_cu < 1) fprintf(stderr, "kernel_launch: occupancy query reports %d blocks per CU\n", per_cu);
        (void)hipGetLastError();
        grid = cus;
    }
    if (grid < 0) return;
    if (hipMemsetAsync((char*)d_ws + WS_CTL, 0, CTL_ZERO_BYTES, stream) != hipSuccess) { fprintf(stderr, "kernel_launch: memset failed\n"); return; }
    Args a{};
    for (int i = 0; i < 29; ++i) a.in[i] = (const float*)d_in[i];
    a.out = (float*)d_out; a.ws = (unsigned char*)d_ws;
#if MK_ONE_LAUNCH
    a.ph_lo = 0; a.ph_hi = N_PHASES;
    hipLaunchKernelGGL(fwd, dim3(grid), dim3(512), LDS_BYTES, stream, a);
#else
    for (int p = 0; p < N_PHASES; ++p) { a.ph_lo = p; a.ph_hi = p + 1; hipLaunchKernelGGL(fwd, dim3(grid), dim3(512), LDS_BYTES, stream, a); }
#endif
    const hipError_t le = hipPeekAtLastError();
    if (le != hipSuccess) fprintf(stderr, "kernel_launch: launch failed: %s\n", hipGetErrorName(le));
}
```

```cpp
#include <hip/hip_runtime.h>
#include <cstdio>
#include <cstdint>

#ifndef MK_ONE_LAUNCH
#define MK_ONE_LAUNCH 1
#endif

#ifndef REP_P0
#define REP_P0 1
#endif
#ifndef REP_UP
#define REP_UP 1
#endif
#ifndef REP_ATT
#define REP_ATT 1
#endif
#ifndef REP_POOL
#define REP_POOL 1
#endif
#ifndef REP_HG
#define REP_HG 1
#endif
#ifndef REP_LN
#define REP_LN 1
#endif
#ifndef REP_DN
#define REP_DN 1
#endif
#ifndef REP_INE
#define REP_INE 1
#endif
#define LAS __attribute__((address_space(3)))
#define GAS __attribute__((address_space(1)))
typedef unsigned short bf16_t;
typedef short bf16x8 __attribute__((ext_vector_type(8)));
typedef short s16x4 __attribute__((ext_vector_type(4)));
typedef float f32x2 __attribute__((ext_vector_type(2)));
typedef float f32x4 __attribute__((ext_vector_type(4)));
typedef float f32x16 __attribute__((ext_vector_type(16)));
typedef unsigned u32x2 __attribute__((ext_vector_type(2)));
typedef unsigned u32x4 __attribute__((ext_vector_type(4)));

constexpr int D = 2048, FF = 5632, MP = 32768, MS = 2048, M = MP + MS, SEQ = 2048, DSEQ = 64, NB_P = 16, NB_S = 32, PAST = 2048;
constexpr int PLE = 256, POOLW = 512, DAW = 1536, NH = 12, HD = 128, IN_EVEN = 5120, IN_ODD = 8192, HGH = 16;
constexpr float ALPHA = 1.4142135623730951f, LN_EPS = 1e-5f, LOG2E = 1.4426950408889634f;
constexpr float QSCALE = 0.125f * LOG2E;
constexpr float LAM_INIT = 0.2f;

constexpr size_t MiB = 1u << 20;
constexpr size_t WS_CTL = 0, CTL_ZERO_BYTES = 1 * MiB;
constexpr size_t WS_TAB = 1 * MiB;
constexpr size_t TAB_BIAS = 0;
constexpr size_t TAB_LB = 16384;
constexpr size_t TAB_PWT = 65536;
constexpr size_t WS_WGU = 2 * MiB;
constexpr size_t WS_WD = WS_WGU + 176 * MiB;
constexpr size_t WS_WINE = WS_WD + 88 * MiB;
constexpr size_t WS_WOUTE = WS_WINE + 20 * MiB;
constexpr size_t WS_WINO = WS_WOUTE + 8 * MiB;
constexpr size_t WS_WOUTO = WS_WINO + 32 * MiB;
constexpr size_t WS_WPG = WS_WOUTO + 8 * MiB;
constexpr size_t WS_WPU = WS_WPG + 16 * MiB;
constexpr size_t WS_X = WS_WPU + 2 * MiB;
constexpr size_t WS_XB = WS_X + 272 * MiB;
constexpr size_t WS_PB = WS_XB + 136 * MiB;
constexpr size_t WS_R = WS_PB + 34 * MiB;
constexpr size_t WS_H = WS_R;
constexpr size_t WS_PU = WS_R;
constexpr size_t WS_U = WS_R;
constexpr size_t WS_QB = WS_U + 68 * MiB;
constexpr size_t WS_KB = WS_QB + 102 * MiB;
constexpr size_t WS_VB = WS_KB + 96 * MiB;
constexpr size_t WS_MIX = WS_R + 816 * MiB;
constexpr size_t WS_QE = WS_R;
constexpr size_t WS_KI = WS_QE + 136 * MiB;
constexpr size_t WS_VV = WS_KI + 136 * MiB;
constexpr size_t WS_GG = WS_VV + 136 * MiB;
constexpr size_t WS_KD = WS_GG + 136 * MiB;
constexpr size_t WS_EB = WS_KD + 136 * MiB;
static_assert(WS_EB + 17 * MiB <= WS_MIX && WS_VB + 96 * MiB <= WS_MIX && WS_H + 374 * MiB <= WS_MIX, "overlay map");
constexpr size_t WS_Z = WS_R + 374 * MiB;
constexpr size_t WS_END = WS_MIX + 136 * MiB;

constexpr int CW_BAR = 4096;
constexpr int CW_QATT = 64;

constexpr int LDS_BYTES = 147456;
constexpr int LDS_ATAB = 131072;
constexpr int LDS_MISC = 139264;

__device__ __forceinline__ unsigned cvt_pk_bf16(float lo, float hi) { unsigned r; asm volatile("v_cvt_pk_bf16_f32 %0, %1, %2" : "=v"(r) : "v"(lo), "v"(hi)); return r; }
__device__ __forceinline__ float bf2f(unsigned short b) { return __builtin_bit_cast(float, (unsigned)b << 16); }
__device__ __forceinline__ float bflo(unsigned w) { return __builtin_bit_cast(float, w << 16); }
__device__ __forceinline__ float bfhi(unsigned w) { return __builtin_bit_cast(float, w & 0xffff0000u); }
__device__ __forceinline__ float fast_exp2(float x) { return __builtin_amdgcn_exp2f(x); }
__device__ __forceinline__ float fast_rcp(float x) { return __builtin_amdgcn_rcpf(x); }
__device__ __forceinline__ float sigmoidf_(float x) { return fast_rcp(1.f + fast_exp2(-x * LOG2E)); }
__device__ __forceinline__ float wave_sum(float v) {
#pragma unroll
    for (int o = 1; o < 64; o <<= 1) v += __shfl_xor(v, o);
    return v;
}
#define LDS_WAIT() asm volatile("s_waitcnt lgkmcnt(0)" ::: "memory")
#define VM_WAIT() asm volatile("s_waitcnt vmcnt(0)" ::: "memory")

namespace pg8 {
constexpr int BM = 256, BK = 64, HALF = 128, HTB = HALF * BK * 2, STAGE_BYTES = 8 * HTB, NXCD = 8, WGM = 8;
__host__ __device__ __forceinline__ int lds_byte(int r, int c) { const int st = (r >> 4) * 2 + (c >> 5), rr = r & 15, cc = c & 31, ob = rr * 64 + cc * 2; return st * 1024 + (ob ^ (((ob >> 9) & 1) << 5)); }
__host__ __device__ __forceinline__ void stage_rc(int b, int& R, int& C) { const int st = b / 1024, sb = b % 1024, swz = sb ^ (((sb >> 9) & 1) << 5); R = (st >> 1) * 16 + swz / 64; C = (st & 1) * 32 + (swz % 64) / 2; }
__host__ __device__ __forceinline__ int perm32(int rho) { const int n = rho >> 4, i = rho & 15; return 8 * (i >> 2) + 4 * n + (i & 3); }
struct Unit { int pm, pn; };
struct Gemm { const bf16_t* A; const bf16_t* Bt; int M, N, K; };
struct StaticOrder {
    int nM, nN, nwg, G, c;
    __host__ __device__ void init(int M_, int N_, int G_, int c_) { nM = M_ / BM; nN = N_ / BM; nwg = nM * nN; G = G_; c = c_; }
    __host__ __device__ bool next(int i, Unit& u) const {
        const long L = (long)i * G + c; if (L >= nwg) return false;
        int wgid = (int)L; { const int q = nwg / NXCD, r = nwg % NXCD, xcd = wgid % NXCD, off = wgid / NXCD; wgid = (xcd < r ? xcd * (q + 1) : r * (q + 1) + (xcd - r) * q) + off; }
        const int nig = WGM * nN, gid = wgid / nig, fm = gid * WGM, gsz = (nM - fm) < WGM ? (nM - fm) : WGM;
        u.pm = fm + ((wgid % nig) % gsz); u.pn = (wgid % nig) / gsz; return true;
    }
    __device__ __forceinline__ void a_ready(const Unit&) const {}
    __device__ __forceinline__ void done(const Unit&) const {}
};

template <class Epi, class Sched, bool ALIGN_EPI = false, bool SP2 = false>
__device__ __forceinline__ void gemm_phase(LAS unsigned char* lds, const Gemm g, const Sched& S, const Epi& E) {
    int tid = threadIdx.x; asm volatile("" : "+v"(tid));
    const int wid = __builtin_amdgcn_readfirstlane(tid >> 6), lane = tid & 63, wr = wid >> 2, wc = wid & 3, fr = lane & 15, fq = lane >> 4;
    int K = g.K; asm volatile("" : "+s"(K));
    const int nt = K / BK;
    unsigned voffA[2], voffB[2];
#pragma unroll
    for (int i = 0; i < 2; ++i) { int R, C; stage_rc(tid * 16 + i * 8192, R, C); const int Rb = Epi::PERM ? ((R & ~31) + perm32(R & 31)) : R;
        voffA[i] = (unsigned)(R * K + C) * 2u; voffB[i] = (unsigned)(Rb * K + C) * 2u; }
    const size_t kstep = (size_t)(BK * 2);
    const size_t hstep = (size_t)HALF * K * 2;
    const size_t tstep = 2 * hstep;
    const unsigned ldsw = (unsigned)wid * 1024u;
    const int aoff = lds_byte(wr * 64 + fr, fq * 8), boff = lds_byte(wc * 32 + fr, fq * 8);
#define PG8_SA(b, h) (((b) * 2 + (h)) * HTB)
#define PG8_SB(b, h) ((4 + (b) * 2 + (h)) * HTB)
#define PG8_STAGE(bufoff, gbase, voff) do { _Pragma("unroll") for (int _i = 0; _i < 2; ++_i) \
        __builtin_amdgcn_global_load_lds((const unsigned*)((const char*)(gbase) + (voff)[_i]), (LAS unsigned*)(lds + (bufoff) + ldsw + _i * 8192), 16, 0, 0); } while (0)
#define PG8_LDA(dst, b, h) do { _Pragma("unroll") for (int m = 0; m < 4; ++m) _Pragma("unroll") for (int k = 0; k < 2; ++k) dst[m][k] = *(const LAS bf16x8*)(lds + PG8_SA(b, h) + aoff + m * 2048 + k * 1024); } while (0)
#define PG8_LDB(dst, b, h) do { _Pragma("unroll") for (int n = 0; n < 2; ++n) _Pragma("unroll") for (int k = 0; k < 2; ++k) dst[n][k] = *(const LAS bf16x8*)(lds + PG8_SB(b, h) + boff + n * 2048 + k * 1024); } while (0)
#define PG8_MMA(ai, bj, At, Bt) do { __builtin_amdgcn_s_setprio(1); _Pragma("unroll") for (int m = 0; m < 4; ++m) _Pragma("unroll") for (int n = 0; n < 2; ++n) _Pragma("unroll") for (int k = 0; k < 2; ++k) \
        acc[ai][bj][m][n] = __builtin_amdgcn_mfma_f32_16x16x32_bf16(Bt[n][k], At[m][k], acc[ai][bj][m][n], 0, 0, 0); __builtin_amdgcn_s_setprio(0); } while (0)
#define PG8_WAIT_V(n) asm volatile("s_waitcnt vmcnt(" #n ")" ::: "memory")
#define PG8_WAIT_L(n) asm volatile("s_waitcnt lgkmcnt(" #n ")" ::: "memory")
#define PG8_BAR __builtin_amdgcn_s_barrier()
#define PG8_SCHED __builtin_amdgcn_sched_barrier(0)
    Unit cur, nxt; int ui = 0;
    if (!S.next(0, cur)) return;
    f32x4 acc[2][2][4][2];
#pragma unroll
    for (int a = 0; a < 2; ++a)
#pragma unroll
        for (int b = 0; b < 2; ++b)
#pragma unroll
            for (int m = 0; m < 4; ++m)
#pragma unroll
                for (int n = 0; n < 2; ++n) acc[a][b][m][n] = (f32x4){0.f, 0.f, 0.f, 0.f};
    bf16x8 At[4][2], B0[2][2], B1[2][2];
    const char* cA = (const char*)g.A + (size_t)cur.pm * tstep; const char* cB = (const char*)g.Bt + (size_t)cur.pn * tstep;
    S.a_ready(cur);
    if constexpr (SP2) {
        PG8_STAGE(PG8_SB(0, 0), cB, voffB); PG8_STAGE(PG8_SB(0, 1), cB + hstep, voffB); PG8_STAGE(PG8_SA(0, 0), cA, voffA); PG8_STAGE(PG8_SA(0, 1), cA + hstep, voffA);
        if (wr == 1) PG8_BAR;
        PG8_WAIT_V(2); PG8_BAR;
        PG8_STAGE(PG8_SB(1, 0), cB + kstep, voffB); PG8_STAGE(PG8_SA(1, 0), cA + kstep, voffA); PG8_STAGE(PG8_SB(1, 1), cB + hstep + kstep, voffB);
        PG8_WAIT_V(6); PG8_BAR;
    } else {
        PG8_STAGE(PG8_SB(0, 0), cB, voffB); PG8_STAGE(PG8_SA(0, 0), cA, voffA); PG8_STAGE(PG8_SB(0, 1), cB + hstep, voffB); PG8_STAGE(PG8_SA(0, 1), cA + hstep, voffA);
        if (wr == 1) PG8_BAR;
        PG8_WAIT_V(4); PG8_BAR;
        PG8_STAGE(PG8_SB(1, 0), cB + kstep, voffB); PG8_STAGE(PG8_SA(1, 0), cA + kstep, voffA); PG8_STAGE(PG8_SB(1, 1), cB + hstep + kstep, voffB);
        PG8_WAIT_V(6); PG8_BAR;
    }
    for (;;) {
        const bool has_next = S.next(ui + 1, nxt);
        const char* nA = has_next ? (const char*)g.A + (size_t)nxt.pm * tstep : cA; const char* nB = has_next ? (const char*)g.Bt + (size_t)nxt.pn * tstep : cB;
        for (int t = 0; t < nt; t += 2) {
            const bool last = (t == nt - 2);
            const char* a1 = cA + (size_t)(t + 1) * kstep;
            const char* a2 = last ? nA : cA + (size_t)(t + 2) * kstep; const char* b2 = last ? nB : cB + (size_t)(t + 2) * kstep;
            const char* a3 = a2 + kstep; const char* b3 = b2 + kstep;
            if (last && has_next) S.a_ready(nxt);
            if constexpr (SP2) {
            PG8_LDB(B0, 0, 0); PG8_LDB(B1, 0, 1); PG8_SCHED; PG8_LDA(At, 0, 0); PG8_STAGE(PG8_SA(1, 1), a1 + hstep, voffA);
            PG8_WAIT_V(8); PG8_WAIT_L(0); PG8_BAR; PG8_MMA(0, 0, At, B0); PG8_MMA(0, 1, At, B1); PG8_BAR; PG8_SCHED;
            PG8_LDA(At, 0, 1); PG8_STAGE(PG8_SB(0, 0), b2, voffB); PG8_STAGE(PG8_SB(0, 1), b2 + hstep, voffB); PG8_STAGE(PG8_SA(0, 0), a2, voffA);
            PG8_WAIT_V(8); PG8_WAIT_L(0); PG8_BAR; PG8_MMA(1, 0, At, B0); PG8_MMA(1, 1, At, B1); PG8_BAR; PG8_SCHED;
            PG8_LDB(B0, 1, 0); PG8_LDB(B1, 1, 1); PG8_SCHED; PG8_LDA(At, 1, 0); PG8_STAGE(PG8_SA(0, 1), a2 + hstep, voffA);
            PG8_WAIT_V(8); PG8_WAIT_L(0); PG8_BAR; PG8_MMA(0, 0, At, B0); PG8_MMA(0, 1, At, B1); PG8_BAR; PG8_SCHED;
            PG8_LDA(At, 1, 1); PG8_STAGE(PG8_SB(1, 0), b3, voffB); PG8_STAGE(PG8_SB(1, 1), b3 + hstep, voffB); PG8_STAGE(PG8_SA(1, 0), a3, voffA);
            PG8_WAIT_V(8); PG8_WAIT_L(0); PG8_BAR; PG8_MMA(1, 0, At, B0); PG8_MMA(1, 1, At, B1); PG8_BAR; PG8_SCHED;
            } else {
            PG8_LDB(B0, 0, 0); PG8_SCHED; PG8_LDA(At, 0, 0); PG8_STAGE(PG8_SA(1, 1), a1 + hstep, voffA);
            PG8_WAIT_L(8); PG8_BAR; PG8_WAIT_L(0); PG8_MMA(0, 0, At, B0); PG8_BAR; PG8_SCHED;
            PG8_LDB(B1, 0, 1); PG8_STAGE(PG8_SB(0, 0), b2, voffB);
            PG8_BAR; PG8_WAIT_L(0); PG8_MMA(0, 1, At, B1); PG8_BAR;
            PG8_LDA(At, 0, 1); PG8_STAGE(PG8_SA(0, 0), a2, voffA);
            PG8_BAR; PG8_WAIT_L(0); PG8_MMA(1, 0, At, B0); PG8_BAR; PG8_SCHED;
            PG8_STAGE(PG8_SB(0, 1), b2 + hstep, voffB);
            PG8_WAIT_V(6); PG8_BAR; PG8_MMA(1, 1, At, B1); PG8_BAR;
            PG8_LDB(B0, 1, 0); PG8_SCHED; PG8_LDA(At, 1, 0); PG8_STAGE(PG8_SA(0, 1), a2 + hstep, voffA);
            PG8_WAIT_L(8); PG8_BAR; PG8_WAIT_L(0); PG8_MMA(0, 0, At, B0); PG8_BAR; PG8_SCHED;
            PG8_LDB(B1, 1, 1); PG8_STAGE(PG8_SB(1, 0), b3, voffB);
            PG8_BAR; PG8_WAIT_L(0); PG8_MMA(0, 1, At, B1); PG8_BAR;
            PG8_LDA(At, 1, 1); PG8_STAGE(PG8_SA(1, 0), a3, voffA);
            PG8_BAR; PG8_WAIT_L(0); PG8_MMA(1, 0, At, B0); PG8_BAR; PG8_SCHED;
            PG8_STAGE(PG8_SB(1, 1), b3 + hstep, voffB);
            PG8_WAIT_V(6); PG8_BAR; PG8_MMA(1, 1, At, B1); PG8_BAR;
            }
        }
        if constexpr (ALIGN_EPI) { if (wr == 0) PG8_BAR; }
        E(acc, cur, wr, wc, fr, fq); S.done(cur);
        if (!has_next) break;
#pragma unroll
        for (int a = 0; a < 2; ++a)
#pragma unroll
            for (int b = 0; b < 2; ++b)
#pragma unroll
                for (int m = 0; m < 4; ++m)
#pragma unroll
                    for (int n = 0; n < 2; ++n) acc[a][b][m][n] = (f32x4){0.f, 0.f, 0.f, 0.f};
        cur = nxt; cA = nA; cB = nB; ++ui;
        if constexpr (ALIGN_EPI) { if (wr == 1) PG8_BAR; }
    }
    PG8_WAIT_V(0);
    if constexpr (!ALIGN_EPI) { if (wr == 0) PG8_BAR; }
    PG8_BAR;
#undef PG8_SA
#undef PG8_SB
#undef PG8_STAGE
#undef PG8_LDA
#undef PG8_LDB
#undef PG8_MMA
#undef PG8_WAIT_V
#undef PG8_WAIT_L
#undef PG8_BAR
#undef PG8_SCHED
}

typedef const f32x4 (&AccRef)[2][2][4][2];
__device__ __forceinline__ u32x4 pack8(f32x4 a, f32x4 b) { u32x4 w; w.x = cvt_pk_bf16(a[0], a[1]); w.y = cvt_pk_bf16(a[2], a[3]); w.z = cvt_pk_bf16(b[0], b[1]); w.w = cvt_pk_bf16(b[2], b[3]); return w; }
__device__ __forceinline__ f32x4 silu4(f32x4 g) { f32x4 r;
#pragma unroll
    for (int i = 0; i < 4; ++i) r[i] = g[i] * fast_rcp(1.f + fast_exp2(-g[i] * LOG2E));
    return r; }

struct EpiFfnUp { static constexpr bool PERM = true;
    bf16_t* H;
    __device__ __forceinline__ void operator()(AccRef acc, const Unit& u, int wr, int wc, int fr, int fq) const {
        const int row0 = u.pm * BM + wr * 64 + fr, col0 = u.pn * HALF + wc * 32 + 8 * fq;
#pragma unroll
        for (int ai = 0; ai < 2; ++ai)
#pragma unroll
            for (int m = 0; m < 4; ++m) { bf16_t* p = H + (size_t)(row0 + ai * HALF + m * 16) * FF + col0;
                const f32x4 h0 = silu4(acc[ai][0][m][0]) * acc[ai][1][m][0], h1 = silu4(acc[ai][0][m][1]) * acc[ai][1][m][1];
                *(u32x4*)p = pack8(h0, h1); }
    }
};
struct EpiResid { static constexpr bool PERM = true;
    const float* xs0; const float* xs1; float* Z; float alpha, beta;
    __device__ __forceinline__ void operator()(AccRef acc, const Unit& u, int wr, int wc, int fr, int fq) const {
        const int row0 = u.pm * BM + wr * 64 + fr, col0 = u.pn * BM + wc * 32 + 8 * fq;
        const float* xs = (u.pm < MP / BM) ? xs0 : xs1 - (size_t)MP * D;
#pragma unroll
        for (int ai = 0; ai < 2; ++ai)
#pragma unroll
            for (int m = 0; m < 4; ++m) { const size_t off = (size_t)(row0 + ai * HALF + m * 16) * D + col0;
#pragma unroll
                for (int bj = 0; bj < 2; ++bj) { const f32x4 x0 = *(const f32x4*)(xs + off + bj * HALF), x1 = *(const f32x4*)(xs + off + bj * HALF + 4);
                    *(f32x4*)(Z + off + bj * HALF) = x0 * alpha + acc[ai][bj][m][0] * beta; *(f32x4*)(Z + off + bj * HALF + 4) = x1 * alpha + acc[ai][bj][m][1] * beta; } }
    }
};
struct EpiInEven { static constexpr bool PERM = true;
    float* U; bf16_t* QB; bf16_t* KB; bf16_t* VB; float* nk0; float* nk1; float* nv0; float* nv1;
    __device__ __forceinline__ void operator()(AccRef acc, const Unit& u, int wr, int wc, int fr, int fq) const {
        const int row0 = u.pm * BM + wr * 64 + fr, cin = wc * 32 + 8 * fq; const bool prompt = u.pm < MP / BM;
        if (u.pn < 2) {
            const int col0 = u.pn * BM + cin;
#pragma unroll
            for (int ai = 0; ai < 2; ++ai)
#pragma unroll
                for (int m = 0; m < 4; ++m) { float* p = U + (size_t)(row0 + ai * HALF + m * 16) * POOLW + col0;
#pragma unroll
                    for (int bj = 0; bj < 2; ++bj) { *(f32x4*)(p + bj * HALF) = acc[ai][bj][m][0]; *(f32x4*)(p + bj * HALF + 4) = acc[ai][bj][m][1]; } }
        } else if (u.pn < 8) {
            const int col0 = (u.pn - 2) * BM + cin;
#pragma unroll
            for (int ai = 0; ai < 2; ++ai)
#pragma unroll
                for (int m = 0; m < 4; ++m) { bf16_t* p = QB + (size_t)(row0 + ai * HALF + m * 16) * DAW + col0;
#pragma unroll
                    for (int bj = 0; bj < 2; ++bj) *(u32x4*)(p + bj * HALF) = pack8(acc[ai][bj][m][0] * QSCALE, acc[ai][bj][m][1] * QSCALE); }
        } else {
            const bool isk = u.pn < 14; const int col0 = (u.pn - (isk ? 8 : 14)) * BM + cin;
            float* o32 = isk ? (prompt ? nk0 : nk1 - (size_t)MP * DAW) : (prompt ? nv0 : nv1 - (size_t)MP * DAW);
            bf16_t* o16 = isk ? KB : VB;
#pragma unroll
            for (int ai = 0; ai < 2; ++ai)
#pragma unroll
                for (int m = 0; m < 4; ++m) { const size_t off = (size_t)(row0 + ai * HALF + m * 16) * DAW + col0;
#pragma unroll
                    for (int bj = 0; bj < 2; ++bj) { *(f32x4*)(o32 + off + bj * HALF) = acc[ai][bj][m][0]; *(f32x4*)(o32 + off + bj * HALF + 4) = acc[ai][bj][m][1];
                        if (prompt) *(u32x4*)(o16 + off + bj * HALF) = pack8(acc[ai][bj][m][0], acc[ai][bj][m][1]); } }
        }
    }
};
__device__ __forceinline__ float scan16(float x) {
#define DPP_SHR(v, n) __builtin_bit_cast(float, __builtin_amdgcn_update_dpp(0, __builtin_bit_cast(int, v), 0x110 + (n), 0xf, 0xf, true))
    x += DPP_SHR(x, 1); x += DPP_SHR(x, 2); x += DPP_SHR(x, 4); x += DPP_SHR(x, 8);
#undef DPP_SHR
    return x; }
struct EpiInOdd { static constexpr bool PERM = true;
    unsigned char* wsb; const float* lbv;
    __device__ __forceinline__ void operator()(AccRef acc, const Unit& u, int wr, int wc, int fr, int fq) const {
        const int row0 = u.pm * BM + wr * 64 + fr, cb = (u.pn >> 1) * HALF + wc * 32 + 8 * fq;
#define AT(T, base, boff) ((T*)(wsb + (size_t)(unsigned)((base) + (boff))))
        if ((u.pn & 1) == 0) {
            const f32x4 lb0 = *(const f32x4*)(lbv + cb), lb1 = *(const f32x4*)(lbv + cb + 4);
            const int l15 = (int)((threadIdx.x & 48u) | 15u);
#pragma unroll
            for (int ai = 0; ai < 2; ++ai)
#pragma unroll
                for (int m = 0; m < 4; ++m) { const int row = row0 + ai * HALF + m * 16; const unsigned off = ((unsigned)row * D + cb) * 2u;
                    f32x4 qe[2], ki[2], kd[2]; float* e = AT(float, (unsigned)WS_EB, ((unsigned)(row >> 4) * D + cb) * 4u);
#pragma unroll
                    for (int n = 0; n < 2; ++n)
#pragma unroll
                        for (int i = 0; i < 4; ++i) { const float q = acc[ai][0][m][n][i], z = acc[ai][1][m][n][i], lb = n ? lb1[i] : lb0[i];
                            const float sg = fast_rcp(1.f + fast_exp2(-z * LOG2E)); const float f = lb + (1.f - lb) * sg, kk = (1.f - lb) * (1.f - sg);
                            const float b = scan16(__builtin_amdgcn_logf(f)); const float bl = __shfl(b, l15, 64);
                            qe[n][i] = q * fast_rcp(1.f + fast_exp2(-q * LOG2E)) * fast_exp2(b); ki[n][i] = kk * fast_exp2(-b); kd[n][i] = kk * fast_exp2(bl - b);
                            if (fr == 15) e[4 * n + i] = fast_exp2(b); }
                    *AT(u32x4, (unsigned)WS_QE, off) = pack8(qe[0], qe[1]); *AT(u32x4, (unsigned)WS_KI, off) = pack8(ki[0], ki[1]); *AT(u32x4, (unsigned)WS_KD, off) = pack8(kd[0], kd[1]);
                    __builtin_amdgcn_sched_barrier(0); }
        } else {
#pragma unroll
            for (int ai = 0; ai < 2; ++ai)
#pragma unroll
                for (int m = 0; m < 4; ++m) { const unsigned off = ((unsigned)(row0 + ai * HALF + m * 16) * D + cb) * 2u;
                    *AT(u32x4, (unsigned)WS_VV, off) = pack8(acc[ai][0][m][0], acc[ai][0][m][1]); *AT(u32x4, (unsigned)WS_GG, off) = pack8(silu4(acc[ai][1][m][0]), silu4(acc[ai][1][m][1])); }
        }
#undef AT
    }
};
struct EpiBf16 { static constexpr bool PERM = true;
    bf16_t* O; int ldc;
    __device__ __forceinline__ void operator()(AccRef acc, const Unit& u, int wr, int wc, int fr, int fq) const {
        const int row0 = u.pm * BM + wr * 64 + fr, col0 = u.pn * BM + wc * 32 + 8 * fq;
#pragma unroll
        for (int ai = 0; ai < 2; ++ai)
#pragma unroll
            for (int m = 0; m < 4; ++m) { bf16_t* p = O + (size_t)(row0 + ai * HALF + m * 16) * ldc + col0;
#pragma unroll
                for (int bj = 0; bj < 2; ++bj) *(u32x4*)(p + bj * HALF) = pack8(acc[ai][bj][m][0], acc[ai][bj][m][1]); }
    }
};
struct EpiPle { static constexpr bool PERM = true;
    float* X; bf16_t* XB; const bf16_t* PU; float* y0; float* y1; int last;
    __device__ __forceinline__ void operator()(AccRef acc, const Unit& u, int wr, int wc, int fr, int fq) const {
        const int row0 = u.pm * BM + wr * 64 + fr, col0 = u.pn * BM + wc * 32 + 8 * fq;
        float* yo = (u.pm < MP / BM) ? y0 : y1 - (size_t)MP * D;
#pragma unroll
        for (int ai = 0; ai < 2; ++ai)
#pragma unroll
            for (int m = 0; m < 4; ++m) { const size_t off = (size_t)(row0 + ai * HALF + m * 16) * D + col0;
#pragma unroll
                for (int bj = 0; bj < 2; ++bj) { const size_t o = off + bj * HALF;
                    const f32x4 x0 = *(const f32x4*)(X + o), x1 = *(const f32x4*)(X + o + 4); const u32x4 pw = *(const u32x4*)(PU + o);
                    const f32x4 p0 = {bflo(pw.x), bfhi(pw.x), bflo(pw.y), bfhi(pw.y)}, p1 = {bflo(pw.z), bfhi(pw.z), bflo(pw.w), bfhi(pw.w)};
                    f32x4 r0, r1;
#pragma unroll
                    for (int i = 0; i < 4; ++i) { r0[i] = x0[i] + sigmoidf_(acc[ai][bj][m][0][i]) * p0[i]; r1[i] = x1[i] + sigmoidf_(acc[ai][bj][m][1][i]) * p1[i]; }
                    if (last) { *(f32x4*)(yo + o) = r0; *(f32x4*)(yo + o + 4) = r1; }
                    else { *(f32x4*)(X + o) = r0; *(f32x4*)(X + o + 4) = r1; *(u32x4*)(XB + o) = pack8(r0, r1); } } }
    }
};
}

#define XB_TMO      128
#define XB_XCNT(j)  (256  + 64 * (j))
#define XB_XSUB(j)  (1280 + 64 * (j))
#define XB_XGEN(j)  (2304 + 64 * (j))
#define XB_TOP      3328
#define XB_TOPGEN   3392
#define XCD_BAR_WORDS 3456
#define XB_SPIN_CAP (1u << 18)
__device__ __forceinline__ unsigned xb_ld(unsigned* p)              { return __hip_atomic_load(p, __ATOMIC_RELAXED, __HIP_MEMORY_SCOPE_AGENT); }
__device__ __forceinline__ unsigned xb_add(unsigned* p, unsigned v) { return __hip_atomic_fetch_add(p, v, __ATOMIC_RELAXED, __HIP_MEMORY_SCOPE_AGENT); }
__device__ __forceinline__ unsigned xb_xcc_id() { return (unsigned)__builtin_amdgcn_s_getreg((3 << 11) | 20) & 0xFu; }
#define XB_SPIN(cond, bar) do { unsigned _sp = 0; while (cond) { __builtin_amdgcn_s_sleep(1); \
    if ((++_sp & 255u) == 0u) { if (xb_ld(&(bar)[XB_TMO])) break; if (_sp > XB_SPIN_CAP) { atomicAdd(&(bar)[XB_TMO], 1u); break; } } } } while (0)
struct XcdBarrier { unsigned* bar; unsigned x; volatile LAS unsigned* st; };
__device__ __forceinline__ XcdBarrier xcd_barrier_post(unsigned* bar, volatile LAS unsigned* st) {
    XcdBarrier b; b.bar = bar; b.x = xb_xcc_id(); b.st = st;
    if (threadIdx.x == 0) (void)xb_add(&bar[XB_XCNT(b.x)], 1u);
    return b;
}
__device__ __forceinline__ void xcd_barrier_complete(unsigned* bar, unsigned x, unsigned& nloc, unsigned& nx) {
    const unsigned G = gridDim.x * gridDim.y * gridDim.z;
    unsigned sum, cnt, mine, sp = 0u;
    for (;;) {
        sum = 0u; cnt = 0u; mine = 0u;
#pragma unroll
        for (unsigned j = 0; j < 16; ++j) { const unsigned c = xb_ld(&bar[XB_XCNT(j)]); sum += c; cnt += (c > 0u) ? 1u : 0u; mine = (j == x) ? c : mine; }
        if (sum == G) break;
        __builtin_amdgcn_s_sleep(1);
        if ((++sp & 255u) == 0u) { if (xb_ld(&bar[XB_TMO])) break; if (sp > XB_SPIN_CAP) { atomicAdd(&bar[XB_TMO], 1u); break; } }
    }
    nloc = mine > 0u ? mine : 1u; nx = cnt > 0u ? cnt : 1u;
}
__device__ __forceinline__ void xcd_barrier(const XcdBarrier& b) {
    asm volatile("s_waitcnt vmcnt(0)" ::: "memory");
    __syncthreads();
    if (threadIdx.x == 0) {
        unsigned* bar = b.bar;
        __builtin_amdgcn_s_waitcnt(0);
        unsigned nloc = b.st[0], nx = b.st[1];
        if (nloc == 0u) { xcd_barrier_complete(bar, b.x, nloc, nx); b.st[0] = nloc; b.st[1] = nx; }
        const unsigned old = xb_add(&bar[XB_XSUB(b.x)], 1u);
        const unsigned gen = old / nloc;
        if (old + 1u == (gen + 1u) * nloc) {
            __builtin_amdgcn_fence(__ATOMIC_RELEASE, "agent");
            asm volatile("s_waitcnt vmcnt(0)" ::: "memory");
            const unsigned og = xb_add(&bar[XB_TOP], 1u);
            const unsigned tg = og / nx;
            if (og + 1u == (tg + 1u) * nx) xb_add(&bar[XB_TOPGEN], 1u);
            else XB_SPIN(xb_ld(&bar[XB_TOPGEN]) == tg, bar);
            __builtin_amdgcn_fence(__ATOMIC_ACQUIRE, "agent");
            xb_add(&bar[XB_XGEN(b.x)], 1u);
            asm volatile("s_waitcnt vmcnt(0)" ::: "memory");
        } else {
            XB_SPIN(xb_ld(&bar[XB_XGEN(b.x)]) == gen, bar);
            __builtin_amdgcn_fence(__ATOMIC_ACQUIRE, "agent");
            asm volatile("s_waitcnt vmcnt(0)" ::: "memory");
        }
    }
    __syncthreads();
}

struct Args { const float* in[29]; float* out; unsigned char* ws; int ph_lo, ph_hi; };
enum { I_XP = 0, I_XS, I_CK, I_CV, I_SPOOL, I_SHG, I_PP, I_PS, I_LNG, I_LNB, I_WG, I_WU, I_WD, I_WPG, I_WPU, I_WINE, I_WOUTE, I_POOLW, I_POOLS,
       I_LQ1, I_LK1, I_LQ2, I_LK2, I_DNG, I_RELB, I_WINO, I_WOUTO, I_HNG, I_LBL };
constexpr size_t O_YP = 0, O_YS = O_YP + (size_t)MP * D, O_KP = O_YS + (size_t)MS * D, O_VP = O_KP + (size_t)MP * DAW, O_KS = O_VP + (size_t)MP * DAW, O_VS = O_KS + (size_t)MS * DAW,
                 O_PLP = O_VS + (size_t)MS * DAW, O_PLS = O_PLP + (size_t)NB_P * 15 * POOLW, O_HGP = O_PLS + (size_t)NB_S * 15 * POOLW, O_HGS = O_HGP + (size_t)NB_P * HGH * 128 * 128,
                 O_END = O_HGS + (size_t)NB_S * HGH * 128 * 128;

__device__ __forceinline__ void tr_item(const float* W, int K, int N, bf16_t* WT, int k0, int n0, int drow0, LAS float* scr, int lane) {
#pragma unroll 8
    for (int i = 0; i < 32; ++i) { const int kk = 2 * i + (lane >> 5); scr[kk * 33 + (lane & 31)] = W[(size_t)(k0 + kk) * N + n0 + (lane & 31)]; }
    LDS_WAIT(); asm volatile("" ::: "memory");
    const int c = lane & 7;
#pragma unroll
    for (int j = 0; j < 4; ++j) { const int n = (lane >> 3) + 8 * j; const LAS float* s = scr + (8 * c) * 33 + n;
        u32x4 o; o.x = cvt_pk_bf16(s[0 * 33], s[1 * 33]); o.y = cvt_pk_bf16(s[2 * 33], s[3 * 33]); o.z = cvt_pk_bf16(s[4 * 33], s[5 * 33]); o.w = cvt_pk_bf16(s[6 * 33], s[7 * 33]);
        *(u32x4*)(WT + (size_t)(drow0 + n) * K + k0 + 8 * c) = o; }
    LDS_WAIT(); asm volatile("" ::: "memory");
}
__device__ __forceinline__ void tr_matrix_item(const float* W, int K, int N, bf16_t* WT, int kind, int item, LAS float* scr, int lane) {
    const int nblk = N / 32, kb = item / nblk, nb = item % nblk, n0 = 32 * nb;
    const int drow0 = kind == 0 ? n0 : kind == 3 ? (512 * ((n0 & 2047) >> 7) + ((n0 >> 11) >> 1) * 256 + ((n0 >> 11) & 1) * 128 + (n0 & 127))
                                   : (256 * (n0 >> 7) + (n0 & 127) + (kind == 2 ? 128 : 0));
    tr_item(W, K, N, WT, 64 * kb, n0, drow0, scr, lane);
}
__device__ __forceinline__ int t5_bucket(int rel) {
    const int n = rel < 0 ? -rel : rel; int b;
    if (n < 8) b = n; else { b = 8 + (n >= 12) + (n >= 16) + (n >= 23) + (n >= 32) + (n >= 46) + (n >= 64) + (n >= 91); }
    return b + (rel > 0 ? 16 : 0);
}
__device__ __forceinline__ void p0_prologue(const Args& a, LAS unsigned char* lds, int vcu, int NGW) {
    int tid = threadIdx.x; asm volatile("" : "+v"(tid)); const int lane = tid & 63, wave = __builtin_amdgcn_readfirstlane(tid >> 6);
    const int gw = vcu * 8 + wave;
    unsigned char* ws = a.ws;
    LAS float* scr = (LAS float*)(lds + wave * 16384);
    constexpr int I_GU = (D / 64) * (FF / 32), I_DN = (FF / 64) * (D / 32), I_INE = (D / 64) * (IN_EVEN / 32), I_SQ = (D / 64) * (D / 32), I_INO = (D / 64) * (IN_ODD / 32), I_PU = (PLE / 64) * (D / 32);
    constexpr int NITEMS = 4 * (2 * I_GU + I_DN) + I_INE + I_SQ + I_INO + I_SQ + 2 * I_SQ + 2 * I_PU;
    constexpr int I_FFN = 2 * I_GU + I_DN;
    for (int it = gw; it < NITEMS; it += NGW) {
        int r = it;
        if (r < 4 * I_FFN) { const int s = r / I_FFN; r -= s * I_FFN;
            bf16_t* wgu = (bf16_t*)(ws + WS_WGU) + (size_t)s * 2 * FF * D; bf16_t* wd = (bf16_t*)(ws + WS_WD) + (size_t)s * D * FF;
            if (r < I_GU) tr_matrix_item(a.in[I_WG] + (size_t)s * D * FF, D, FF, wgu, 1, r, scr, lane);
            else if (r < 2 * I_GU) tr_matrix_item(a.in[I_WU] + (size_t)s * D * FF, D, FF, wgu, 2, r - I_GU, scr, lane);
            else tr_matrix_item(a.in[I_WD] + (size_t)s * FF * D, FF, D, wd, 0, r - 2 * I_GU, scr, lane);
            continue; }
        r -= 4 * I_FFN;
        if (r < I_INE) { tr_matrix_item(a.in[I_WINE], D, IN_EVEN, (bf16_t*)(ws + WS_WINE), 0, r, scr, lane); continue; } r -= I_INE;
        if (r < I_SQ) { tr_matrix_item(a.in[I_WOUTE], D, D, (bf16_t*)(ws + WS_WOUTE), 0, r, scr, lane); continue; } r -= I_SQ;
        if (r < I_INO) { tr_matrix_item(a.in[I_WINO], D, IN_ODD, (bf16_t*)(ws + WS_WINO), 3, r, scr, lane); continue; } r -= I_INO;
        if (r < I_SQ) { tr_matrix_item(a.in[I_WOUTO], D, D, (bf16_t*)(ws + WS_WOUTO), 0, r, scr, lane); continue; } r -= I_SQ;
        if (r < I_SQ) { tr_matrix_item(a.in[I_WPG], D, D, (bf16_t*)(ws + WS_WPG), 0, r, scr, lane); continue; } r -= I_SQ;
        if (r < I_SQ) { tr_matrix_item(a.in[I_WPG] + (size_t)D * D, D, D, (bf16_t*)(ws + WS_WPG) + (size_t)D * D, 0, r, scr, lane); continue; } r -= I_SQ;
        if (r < I_PU) { tr_matrix_item(a.in[I_WPU], PLE, D, (bf16_t*)(ws + WS_WPU), 0, r, scr, lane); continue; } r -= I_PU;
        tr_matrix_item(a.in[I_WPU] + (size_t)PLE * D, PLE, D, (bf16_t*)(ws + WS_WPU) + (size_t)D * PLE, 0, r, scr, lane);
    }
    { const size_t gt = (size_t)gw * 64 + lane, GT = (size_t)NGW * 64; bf16_t* XB = (bf16_t*)(ws + WS_XB);
      for (size_t i = gt; i < (size_t)M * D / 8; i += GT) { const size_t e = i * 8; const float* src = e < (size_t)MP * D ? a.in[I_XP] + e : a.in[I_XS] + (e - (size_t)MP * D);
          const f32x4 v0 = *(const f32x4*)src, v1 = *(const f32x4*)(src + 4); *(u32x4*)(XB + e) = pg8::pack8(v0, v1); }
      bf16_t* PB = (bf16_t*)(ws + WS_PB);
      for (size_t i = gt; i < (size_t)2 * M * PLE / 8; i += GT) { const size_t e = i * 8; const int l = (int)(e / ((size_t)M * PLE)); const size_t r = e - (size_t)l * M * PLE;
          const float* src = r < (size_t)MP * PLE ? a.in[I_PP] + (size_t)l * MP * PLE + r : a.in[I_PS] + (size_t)l * MS * PLE + (r - (size_t)MP * PLE);
          const f32x4 v0 = *(const f32x4*)src, v1 = *(const f32x4*)(src + 4); *(u32x4*)(PB + e) = pg8::pack8(v0, v1); }
      float* tb = (float*)(ws + WS_TAB + TAB_BIAS);
      for (size_t i = gt; i < (size_t)NH * 256; i += GT) { const int h = (int)(i >> 8), idx = (int)(i & 255); const int rel = idx - 191;
          const float* rb = a.in[I_RELB]; tb[i] = idx < 255 ? (rb[t5_bucket(rel) * NH + h] - rb[15 * NH + h]) * LOG2E : 0.f; }
      float* lbv = (float*)(ws + WS_TAB + TAB_LB);
      for (size_t i = gt; i < (size_t)D; i += GT) { const float l0 = a.in[I_LBL][i], l1 = a.in[I_LBL][D + i]; const float mx = fmaxf(l0, l1), e0 = __expf(l0 - mx), e1 = __expf(l1 - mx); lbv[i] = e1 / (e0 + e1); }
      bf16_t* pwt = (bf16_t*)(ws + WS_TAB + TAB_PWT);
      for (size_t i = gt; i < (size_t)4 * 128 * 128; i += GT) { const int g = (int)(i >> 14), n = (int)((i >> 7) & 127), k = (int)(i & 127);
          pwt[i] = (bf16_t)(cvt_pk_bf16(a.in[I_POOLW][((size_t)g * 128 + k) * 128 + n], 0.f) & 0xffffu); }
    }
}

__device__ __forceinline__ void ln_phase(const float* Z, float* X, bf16_t* XB, const float* g, const float* b, int vcu, int NGW) {
    int tid = threadIdx.x; asm volatile("" : "+v"(tid)); const int lane = tid & 63, wave = __builtin_amdgcn_readfirstlane(tid >> 6);
    const int gw = vcu * 8 + wave;
    f32x4 gv[8], bv[8];
#pragma unroll
    for (int j = 0; j < 8; ++j) { gv[j] = *(const f32x4*)(g + (j * 64 + lane) * 4); bv[j] = *(const f32x4*)(b + (j * 64 + lane) * 4); }
    for (int row = gw; row < M; row += NGW) {
        float* xr = X + (size_t)row * D; const float* zr = Z + (size_t)row * D; f32x4 v[8]; float s = 0.f;
#pragma unroll
        for (int j = 0; j < 8; ++j) { v[j] = *(const f32x4*)(zr + (j * 64 + lane) * 4); s += (v[j][0] + v[j][1]) + (v[j][2] + v[j][3]); }
        const float mean = wave_sum(s) * (1.f / D); float s2 = 0.f;
#pragma unroll
        for (int j = 0; j < 8; ++j) { v[j] = v[j] - mean; s2 += (v[j][0] * v[j][0] + v[j][1] * v[j][1]) + (v[j][2] * v[j][2] + v[j][3] * v[j][3]); }
        const float rstd = 1.f / sqrtf(wave_sum(s2) * (1.f / D) + LN_EPS);
        bf16_t* xb = XB + (size_t)row * D;
#pragma unroll
        for (int j = 0; j < 8; ++j) { const f32x4 o = v[j] * rstd * gv[j] + bv[j]; *(f32x4*)(xr + (j * 64 + lane) * 4) = o;
            u32x2 w; w.x = cvt_pk_bf16(o[0], o[1]); w.y = cvt_pk_bf16(o[2], o[3]); *(u32x2*)(xb + (j * 64 + lane) * 4) = w; }
    }
}

#define KSWZ(row, colB) ((row) * 256 + ((colB) ^ (((row) & 7) << 4)))
__device__ __forceinline__ int crow(int r, int hi) { return (r & 3) + 8 * (r >> 2) + 4 * hi; }
__device__ __forceinline__ void pool_phase(const Args& a, LAS unsigned char* lds) {
    int tid = threadIdx.x; asm volatile("" : "+v"(tid)); const int lane = tid & 63, wave = __builtin_amdgcn_readfirstlane(tid >> 6);
    const float* U = (const float*)(a.ws + WS_U); bf16_t* MIX = (bf16_t*)(a.ws + WS_MIX); const bf16_t* pwt = (const bf16_t*)(a.ws + WS_TAB + TAB_PWT);
    LAS float* full = (LAS float*)lds;
    LAS unsigned char* pa = lds + 40960;
    const int r32 = lane & 31, hi = lane >> 5;
    for (int unit = blockIdx.x; unit < (M / 64) * 4; unit += gridDim.x) {
        const int rb = unit >> 2, g = unit & 3, r0 = rb * 64; const bool smp = r0 >= MP;
        const int t0 = smp ? 0 : (r0 & (SEQ - 1)); const int bs = smp ? (r0 - MP) / DSEQ : 0;
        for (int p = tid; p < 79 * 32; p += 512) { const int i = p >> 5, c4 = (p & 31) * 4; const int t = t0 - 15 + i; f32x4 v = {0.f, 0.f, 0.f, 0.f};
            if (t >= 0) v = *(const f32x4*)(U + (size_t)(r0 - 15 + i) * POOLW + g * 128 + c4);
            else if (smp) v = *(const f32x4*)(a.in[I_SPOOL] + ((size_t)bs * 15 + (15 + t)) * POOLW + g * 128 + c4);
            *(LAS f32x4*)(full + i * 128 + c4) = v; }
        __syncthreads();
        { const int c = tid & 127, rq = tid >> 7, w = 2 << g;
          for (int tt = rq * 16; tt < rq * 16 + 16; ++tt) { float s = 0.f;
              for (int j = 0; j < w; ++j) s += full[(15 + tt - j) * 128 + c];
              const int cnt = smp ? w : ((t0 + tt + 1) < w ? (t0 + tt + 1) : w);
              const float pv = s / (float)cnt - full[(15 + tt) * 128 + c];
              *(LAS bf16_t*)(pa + KSWZ(tt, c * 2)) = (bf16_t)(cvt_pk_bf16(pv, 0.f) & 0xffffu); } }
        __syncthreads();
        { const int rt = wave >> 2, ct = wave & 3; f32x16 acc = {};
#pragma unroll
          for (int s = 0; s < 8; ++s) { const bf16x8 af = *(const LAS bf16x8*)(pa + KSWZ(32 * rt + r32, (16 * s + 8 * hi) * 2));
              const bf16x8 bfr = *(const bf16x8*)(pwt + ((size_t)g * 128 + 32 * ct + r32) * 128 + 16 * s + 8 * hi);
              acc = __builtin_amdgcn_mfma_f32_32x32x16_bf16(af, bfr, acc, 0, 0, 0); }
          const int n = g * 128 + 32 * ct + r32; const float sc = a.in[I_POOLS][n];
#pragma unroll
          for (int r = 0; r < 16; ++r) { const int row = r0 + 32 * rt + crow(r, hi); MIX[(size_t)row * D + n] = (bf16_t)(cvt_pk_bf16(acc[r] * sc, 0.f) & 0xffffu); } }
        __syncthreads();
    }
    { float* op = a.out + O_PLP; float* os = a.out + O_PLS;
      for (int i = blockIdx.x * 512 + tid; i < NB_P * 15 * POOLW; i += gridDim.x * 512) { const int c = i & 511, j = (i >> 9) % 15, b = i / (15 * POOLW); op[i] = U[((size_t)b * SEQ + SEQ - 15 + j) * POOLW + c]; }
      for (int i = blockIdx.x * 512 + tid; i < NB_S * 15 * POOLW; i += gridDim.x * 512) { const int c = i & 511, j = (i >> 9) % 15, b = i / (15 * POOLW); os[i] = U[((size_t)MP + (size_t)b * DSEQ + DSEQ - 15 + j) * POOLW + c]; } }
}

namespace att {
__device__ __forceinline__ int v_st(int k, int c) { const int kk = (k & ~0xC) | ((k & 4) << 1) | ((k & 8) >> 1); return ((kk >> 3) * 4 + (c >> 5)) * 512 + ((kk & 7) * 32 + (c & 31)) * 2; }
__device__ __forceinline__ int v_rd_base(int lane) { return ((lane & 3) << 3) | (((lane >> 2) & 3) << 6) | (((lane >> 4) & 1) << 5) | (((lane >> 5) & 1) << 8); }
constexpr int v_rd_off(int d0, int ks, int half) { return d0 * 512 + ks * 4096 + half * 2048; }
template <int OFF> __device__ __forceinline__ s16x4 tr_read(unsigned vb) { s16x4 r; asm volatile("ds_read_b64_tr_b16 %0, %1 offset:%2" : "=&v"(r) : "v"(vb), "i"(OFF) : "memory"); return r; }
template <int D0, int H> __device__ __forceinline__ void pv_half(f32x16& od, unsigned vb, bf16x8 pa0, bf16x8 pa1) {
    const s16x4 l0 = tr_read<v_rd_off(D0, 2 * H, 0)>(vb), h0 = tr_read<v_rd_off(D0, 2 * H, 1)>(vb), l1 = tr_read<v_rd_off(D0, 2 * H + 1, 0)>(vb), h1 = tr_read<v_rd_off(D0, 2 * H + 1, 1)>(vb);
    asm volatile("s_waitcnt lgkmcnt(0)" ::: "memory"); __builtin_amdgcn_sched_barrier(0);
#define PK(L, H_) (bf16x8){L[0], L[1], L[2], L[3], H_[0], H_[1], H_[2], H_[3]}
    od = __builtin_amdgcn_mfma_f32_32x32x16_bf16(pa0, PK(l0, h0), od, 0, 0, 0);
    od = __builtin_amdgcn_mfma_f32_32x32x16_bf16(pa1, PK(l1, h1), od, 0, 0, 0);
#undef PK
}
__device__ __forceinline__ u32x4 ld_bf8(const bf16_t* p) { return *(const u32x4*)p; }
__device__ __forceinline__ u32x4 ld_f8(const float* p) { const f32x4 a = *(const f32x4*)p, b = *(const f32x4*)(p + 4); return pg8::pack8(a, b); }

__device__ __forceinline__ void scores_h(f32x16& a, f32x16& b, const LAS unsigned char* Ks, int krow, const bf16x8* qr, int hi, bool near, const LAS float* tb, int idx) {
    a = (f32x16){}; b = (f32x16){};
#pragma unroll
    for (int d0 = 0; d0 < 4; ++d0) { const bf16x8 k0 = *(const LAS bf16x8*)(Ks + KSWZ(krow, (d0 * 16 + hi * 8) * 2)); a = __builtin_amdgcn_mfma_f32_32x32x16_bf16(k0, qr[d0], a, 0, 0, 0); }
#pragma unroll
    for (int d0 = 4; d0 < 8; ++d0) { const bf16x8 k0 = *(const LAS bf16x8*)(Ks + KSWZ(krow, (d0 * 16 + hi * 8) * 2)); b = __builtin_amdgcn_mfma_f32_32x32x16_bf16(k0, qr[d0], b, 0, 0, 0); }
    if (near) {
#pragma unroll
        for (int r = 0; r < 16; ++r) { const float v0 = tb[idx + (r & 3) + 8 * (r >> 2)]; a[r] += v0; b[r] += v0; }
    }
}
__device__ __forceinline__ float xhalf_max(float v) { auto rr = __builtin_amdgcn_permlane32_swap(__float_as_uint(v), __float_as_uint(v), false, false); return fmaxf(__uint_as_float(rr[0]), __uint_as_float(rr[1])); }
__device__ __forceinline__ float xhalf_sum(float v) { auto rr = __builtin_amdgcn_permlane32_swap(__float_as_uint(v), __float_as_uint(v), false, false); return __uint_as_float(rr[0]) + __uint_as_float(rr[1]); }
__device__ __forceinline__ void stat_update(float& m, float& l, const f32x16& x) {
    float mx = x[0];
#pragma unroll
    for (int r = 1; r < 16; ++r) mx = fmaxf(mx, x[r]);
    mx = xhalf_max(mx); const float mn = fmaxf(m, mx); float s = 0.f;
#pragma unroll
    for (int r = 0; r < 16; ++r) s += fast_exp2(x[r] - mn);
    l = l * fast_exp2(m - mn) + s; m = mn;
}
#define PK4(P, BASE, OUT) do { unsigned a0_ = cvt_pk_bf16(P[BASE + 0], P[BASE + 1]), a1_ = cvt_pk_bf16(P[BASE + 2], P[BASE + 3]);   \
    unsigned b0_ = cvt_pk_bf16(P[BASE + 4], P[BASE + 5]), b1_ = cvt_pk_bf16(P[BASE + 6], P[BASE + 7]);                              \
    auto r0_ = __builtin_amdgcn_permlane32_swap(a0_, b0_, false, false); auto r1_ = __builtin_amdgcn_permlane32_swap(a1_, b1_, false, false); \
    u32x4 w_ = {r0_[0], r1_[0], r0_[1], r1_[1]}; OUT = __builtin_bit_cast(bf16x8, w_); } while (0)

template <bool SAMPLE>
__device__ __forceinline__ void attn_unit(const Args& a, LAS unsigned char* lds, int uidx, int tid_in, int wave, float lam) {
    int tid = tid_in; asm volatile("" : "+v"(tid));
    const int lane = tid & 63, r32 = lane & 31, hi = lane >> 5;
    const bf16_t* QB = (const bf16_t*)(a.ws + WS_QB); const bf16_t* KB = (const bf16_t*)(a.ws + WS_KB); const bf16_t* VB = (const bf16_t*)(a.ws + WS_VB); bf16_t* MIX = (bf16_t*)(a.ws + WS_MIX);
    LAS float* tb = (LAS float*)(lds + LDS_ATAB);
    int b, h, qb = 0, h0 = 0;
    if (SAMPLE) { b = uidx / 3; h0 = (uidx % 3) * 4; h = h0 + (wave >> 1); }
    else { const int k = uidx; qb = 7 - k / (NB_P * NH); const int bh = k % (NB_P * NH); b = bh / NH; h = bh % NH; }
    const int nsteps = SAMPLE ? 33 : qb + 1;
    const int cw = SAMPLE ? 32 : 4 * qb + (wave >> 1);
    const size_t qrow = SAMPLE ? (size_t)MP + (size_t)b * DSEQ + 32 * (wave & 1) : (size_t)b * SEQ + qb * 256 + 32 * wave;
    if (SAMPLE) { for (int i = tid; i < 1024; i += 512) tb[i] = ((const float*)(a.ws + WS_TAB + TAB_BIAS))[(h0 + (i >> 8)) * 256 + (i & 255)]; }
    else { if (tid < 256) tb[tid] = ((const float*)(a.ws + WS_TAB + TAB_BIAS))[h * 256 + tid]; }
    const LAS float* tbw = tb + (SAMPLE ? 256 * (wave >> 1) : 0);
    bf16x8 qr[8];
    { const bf16_t* qp = QB + (qrow + r32) * DAW + h * HD + hi * 8;
#pragma unroll
      for (int d0 = 0; d0 < 8; ++d0) qr[d0] = *(const bf16x8*)(qp + d0 * 16); }
    const int sr = tid >> 4, sc = (tid & 15) * 8;
    const int kst0 = KSWZ(sr, sc * 2), kst1 = KSWZ(32 + sr, sc * 2), vst0 = v_st(sr, sc), vst1 = v_st(32 + sr, sc);
    float m1 = -1e30f, l1 = 0.f, m2 = -1e30f, l2 = 0.f;
    const int jlo = SAMPLE ? (wave >> 1) : 0, jhi = SAMPLE ? (wave >> 1) : 3;
    const int idxw = -64 * cw - 32 * (wave & 1) - r32 + 191 + 4 * hi;
#define ATT_STAGE(WITHV) do { _Pragma("unroll 1") for (int j = 0; j < 4; ++j) { LAS unsigned char* Ks = lds + j * 32768; LAS unsigned char* Vs = Ks + 16384;                    \
        if (SAMPLE) { const int hh = h0 + j; const float* kp; const float* vp; size_t rs;                                                                                  \
            if (s < 32) { const size_t o_ = (((size_t)b * PAST + 64 * s + sr) * NH + hh) * HD + sc; kp = a.in[I_CK] + o_; vp = a.in[I_CV] + o_; rs = (size_t)32 * NH * HD; }        \
            else { const size_t o_ = ((size_t)b * DSEQ + sr) * DAW + hh * HD + sc; kp = a.out + O_KS + o_; vp = a.out + O_VS + o_; rs = (size_t)32 * DAW; }                      \
            { const u32x4 k0 = ld_f8(kp), k1 = ld_f8(kp + rs); *(LAS u32x4*)(Ks + kst0) = k0; *(LAS u32x4*)(Ks + kst1) = k1; }                                             \
            if (WITHV) { const u32x4 v0 = ld_f8(vp), v1 = ld_f8(vp + rs); *(LAS u32x4*)(Vs + vst0) = v0; *(LAS u32x4*)(Vs + vst1) = v1; }                                    \
        } else { const size_t o_ = ((size_t)b * SEQ + 64 * (4 * s + j) + sr) * DAW + h * HD + sc;                                                                        \
            { const u32x4 k0 = ld_bf8(KB + o_), k1 = ld_bf8(KB + o_ + (size_t)32 * DAW); *(LAS u32x4*)(Ks + kst0) = k0; *(LAS u32x4*)(Ks + kst1) = k1; }                   \
            if (WITHV) { const u32x4 v0 = ld_bf8(VB + o_), v1 = ld_bf8(VB + o_ + (size_t)32 * DAW); *(LAS u32x4*)(Vs + vst0) = v0; *(LAS u32x4*)(Vs + vst1) = v1; } } } } while (0)
#pragma unroll 1
    for (int s = 0; s < nsteps; ++s) {
        ATT_STAGE(false);
        __syncthreads();
#pragma unroll 1
        for (int j = jlo; j <= jhi; ++j) { const int t = SAMPLE ? s : 4 * s + j;
            if (t > cw) break;
            const bool near = t >= cw - 2; const LAS unsigned char* Ks = lds + j * 32768; const int idx = near ? idxw + 64 * t : 0;
#pragma unroll
            for (int hf = 0; hf < 2; ++hf) { f32x16 x, y; scores_h(x, y, Ks, 32 * hf + r32, qr, hi, near, tbw, idx + 32 * hf); stat_update(m1, l1, x); stat_update(m2, l2, y); } }
        __syncthreads();
    }
    const float il1 = fast_rcp(xhalf_sum(l1)), cl2 = lam * fast_rcp(xhalf_sum(l2));
    f32x16 o[4] = {};
#pragma unroll 1
    for (int s = 0; s < nsteps; ++s) {
        ATT_STAGE(true);
        __syncthreads();
#pragma unroll 1
        for (int j = jlo; j <= jhi; ++j) { const int t = SAMPLE ? s : 4 * s + j;
            if (t > cw) break;
            const LAS unsigned char* Ks = lds + j * 32768; const bool near = t >= cw - 2; const int idx = near ? idxw + 64 * t : 0;
            const unsigned vb = (unsigned)(size_t)(Ks + 16384) + (unsigned)v_rd_base(lane);
            { f32x16 x, y; scores_h(x, y, Ks, r32, qr, hi, near, tbw, idx);
#pragma unroll
              for (int r = 0; r < 16; ++r) x[r] = fast_exp2(x[r] - m1) * il1 - fast_exp2(y[r] - m2) * cl2;
              bf16x8 pa0, pa1; PK4(x, 0, pa0); PK4(x, 8, pa1);
              pv_half<0, 0>(o[0], vb, pa0, pa1); pv_half<1, 0>(o[1], vb, pa0, pa1); pv_half<2, 0>(o[2], vb, pa0, pa1); pv_half<3, 0>(o[3], vb, pa0, pa1); }
            { f32x16 x, y; scores_h(x, y, Ks, 32 + r32, qr, hi, near, tbw, idx + 32);
#pragma unroll
              for (int r = 0; r < 16; ++r) x[r] = fast_exp2(x[r] - m1) * il1 - fast_exp2(y[r] - m2) * cl2;
              bf16x8 pa0, pa1; PK4(x, 0, pa0); PK4(x, 8, pa1);
              pv_half<0, 1>(o[0], vb, pa0, pa1); pv_half<1, 1>(o[1], vb, pa0, pa1); pv_half<2, 1>(o[2], vb, pa0, pa1); pv_half<3, 1>(o[3], vb, pa0, pa1); } }
        __syncthreads();
    }
#undef ATT_STAGE
    float ss[16];
#pragma unroll
    for (int r = 0; r < 16; ++r) { float v = o[0][r] * o[0][r] + o[1][r] * o[1][r] + o[2][r] * o[2][r] + o[3][r] * o[3][r];
#pragma unroll
        for (int sft = 1; sft < 32; sft <<= 1) v += __shfl_xor(v, sft);
        ss[r] = (1.f - LAM_INIT) / sqrtf(v * (1.f / HD) + LN_EPS); }
    float gq[4];
#pragma unroll
    for (int d0 = 0; d0 < 4; ++d0) gq[d0] = a.in[I_DNG][32 * d0 + r32];
#pragma unroll
    for (int r = 0; r < 16; ++r) { bf16_t* op = MIX + (qrow + crow(r, hi)) * D + POOLW + h * HD + r32;
#pragma unroll
        for (int d0 = 0; d0 < 4; ++d0) op[32 * d0] = (bf16_t)(cvt_pk_bf16(o[d0][r] * ss[r] * gq[d0], 0.f) & 0xffffu); }
}
constexpr int N_SAMPLE_UNITS = NB_S * 3, N_PROMPT_UNITS = NB_P * NH * 8, N_UNITS = N_SAMPLE_UNITS + N_PROMPT_UNITS;
}

__device__ __forceinline__ void attn_phase(const Args& a, LAS unsigned char* lds, int rep) {
    int tid = threadIdx.x; asm volatile("" : "+v"(tid)); const int lane = tid & 63, wave = __builtin_amdgcn_readfirstlane(tid >> 6);
    float lam;
    { const float p1 = a.in[I_LQ1][lane] * a.in[I_LK1][lane], p2 = a.in[I_LQ2][lane] * a.in[I_LK2][lane]; lam = __expf(wave_sum(p1)) - __expf(wave_sum(p2)) + LAM_INIT; }
    unsigned* qhead = (unsigned*)(a.ws + WS_CTL) + CW_QATT + 64 * rep;
    volatile LAS unsigned* bc = (volatile LAS unsigned*)(lds + LDS_MISC + 64);
    for (;;) {
        if (tid == 0) *bc = atomicAdd(qhead, 1u);
        __syncthreads();
        const int u = (int)*bc;
        __syncthreads();
        if (u >= att::N_UNITS) break;
        if (u < att::N_SAMPLE_UNITS) att::attn_unit<true>(a, lds, u, tid, wave, lam);
        else att::attn_unit<false>(a, lds, u - att::N_SAMPLE_UNITS, tid, wave, lam);
    }
}

namespace hg {
constexpr int SLOT = 21504, NSLOT = 5, OT = NSLOT * SLOT;
__device__ __forceinline__ s16x4 trr(unsigned addr) { s16x4 r; asm volatile("ds_read_b64_tr_b16 %0, %1" : "=&v"(r) : "v"(addr) : "memory"); return r; }
#define DPP_ROR(v, n) __builtin_bit_cast(float, __builtin_amdgcn_update_dpp(0, __builtin_bit_cast(int, v), 0x120 + (n), 0xf, 0xf, false))
__device__ __forceinline__ float sum16(float x) { x += DPP_ROR(x, 8); x += DPP_ROR(x, 4); x += DPP_ROR(x, 2); x += DPP_ROR(x, 1); return x; }
#undef DPP_ROR
}
__device__ __forceinline__ void hgrn_phase(const Args& a, LAS unsigned char* lds) {
    int tid = threadIdx.x; asm volatile("" : "+v"(tid)); const int lane = tid & 63, w = __builtin_amdgcn_readfirstlane(tid >> 6);
    const int g = lane >> 4, el = lane & 15;
    unsigned srcoff[5]; int dstoff[5];
#pragma unroll
    for (int i = 0; i < 5; ++i) { const int piece = 5 * (w & 3) + i, arr = piece >> 2, rg = piece & 3, row = 4 * rg + g;
        const unsigned abase = arr == 0 ? 0u : arr == 1 ? (unsigned)(WS_KI - WS_QE) : arr == 2 ? (unsigned)(WS_KD - WS_QE) : arr == 3 ? (unsigned)(WS_VV - WS_QE) : (unsigned)(WS_GG - WS_QE);
        srcoff[i] = abase + (unsigned)row * (D * 2) + (unsigned)((el ^ row) << 4); dstoff[i] = arr * 4096 + rg * 1024; }
    const unsigned aq0 = (unsigned)(el * 256 + 8 * (g & 1)), aqx = (unsigned)(g >> 1);
    const int tk = 4 * g + (el >> 2), pp = el & 3;
    const unsigned atr = (unsigned)(tk * 256 + 8 * (pp & 1));
    const int ftok = 4 * (w & 3) + g;
    const f32x4 gn0 = *(const f32x4*)(a.in[I_HNG] + 8 * el), gn1 = *(const f32x4*)(a.in[I_HNG] + 8 * el + 4);
    for (int unit = blockIdx.x; unit < NB_P * HGH + NB_S * HGH; unit += gridDim.x) {
        const bool smp = unit >= NB_P * HGH; const int bh = smp ? unit - NB_P * HGH : unit; const int b = bh >> 4, h = bh & 15;
        const int NC = smp ? DSEQ / 16 : SEQ / 16; const size_t row0 = smp ? (size_t)MP + (size_t)b * DSEQ : (size_t)b * SEQ;
        f32x4 S[8];
        if (smp) { const float* sp = a.in[I_SHG] + (((size_t)b * HGH + h) * 128 + 4 * g) * 128 + 16 * w + el;
#pragma unroll
            for (int mt = 0; mt < 8; ++mt)
#pragma unroll
                for (int r = 0; r < 4; ++r) S[mt][r] = sp[(size_t)(16 * mt + r) * 128]; }
        else {
#pragma unroll
            for (int mt = 0; mt < 8; ++mt) S[mt] = (f32x4){0.f, 0.f, 0.f, 0.f}; }
        const unsigned char* ubase = a.ws + WS_QE + row0 * (D * 2) + (size_t)h * 256;
        const float* ebase = (const float*)(a.ws + WS_EB) + (row0 >> 4) * D + h * 128 + (lane & 31) * 4;
        bf16_t* obase = (bf16_t*)(a.ws + WS_MIX) + (row0 + ftok) * D + h * 128 + 8 * el;
        asm volatile("s_waitcnt vmcnt(0)" ::: "memory");
#pragma unroll
        for (int mt = 0; mt < 8; ++mt) asm volatile("" : "+v"(S[mt]));
#define HG_DMA(c, slotp) do { if (w < 4) { const int cc_ = (c) < NC ? (c) : NC - 1; const unsigned char* ub_ = ubase + (size_t)cc_ * (16 * D * 2);                     \
        _Pragma("unroll") for (int i_ = 0; i_ < 5; ++i_) __builtin_amdgcn_global_load_lds((const unsigned*)(ub_ + srcoff[i_]), (LAS unsigned*)((slotp) + dstoff[i_]), 16, 0, 0);     \
        if (w == 0) __builtin_amdgcn_global_load_lds((const unsigned*)(ebase + (size_t)cc_ * D), (LAS unsigned*)((slotp) + 20480), 16, 0, 0); } } while (0)
        HG_DMA(0, lds); HG_DMA(1, lds + hg::SLOT); HG_DMA(2, lds + 2 * hg::SLOT);
        int si = 0;
#pragma unroll 1
        for (int c = 0; c <= NC; ++c) {
            if (w == 0) asm volatile("s_waitcnt vmcnt(12)" ::: "memory"); else if (w < 4) asm volatile("s_waitcnt vmcnt(10)" ::: "memory");
            asm volatile("s_waitcnt lgkmcnt(0)" ::: "memory"); __builtin_amdgcn_s_barrier(); asm volatile("" ::: "memory");
            { const int s3 = si + 3 >= hg::NSLOT ? si + 3 - hg::NSLOT : si + 3; HG_DMA(c + 3, lds + s3 * hg::SLOT); }
            const LAS unsigned char* sl = lds + si * hg::SLOT; const unsigned slb = (unsigned)(size_t)sl;
            if (c < NC) {
                f32x4 oacc = {0.f, 0.f, 0.f, 0.f};
                bf16x8 qf[4];
#pragma unroll
                for (int ks = 0; ks < 4; ++ks) { const unsigned c0 = (unsigned)(4 * ks) + aqx;
                    const u32x2 lo = *(const LAS u32x2*)(sl + aq0 + (((c0) ^ (unsigned)el) << 4)), hi2 = *(const LAS u32x2*)(sl + aq0 + (((c0 + 2) ^ (unsigned)el) << 4));
                    u32x4 qv = {lo.x, lo.y, hi2.x, hi2.y}; qf[ks] = __builtin_bit_cast(bf16x8, qv);
                    u32x4 sv = {cvt_pk_bf16(S[2 * ks][0], S[2 * ks][1]), cvt_pk_bf16(S[2 * ks][2], S[2 * ks][3]), cvt_pk_bf16(S[2 * ks + 1][0], S[2 * ks + 1][1]), cvt_pk_bf16(S[2 * ks + 1][2], S[2 * ks + 1][3])};
                    oacc = __builtin_amdgcn_mfma_f32_16x16x32_bf16(qf[ks], __builtin_bit_cast(bf16x8, sv), oacc, 0, 0, 0); }
                f32x4 at = {0.f, 0.f, 0.f, 0.f};
#pragma unroll
                for (int ks = 0; ks < 4; ++ks) { const unsigned c0 = (unsigned)(4 * ks) + aqx;
                    const u32x2 lo = *(const LAS u32x2*)(sl + 4096 + aq0 + (((c0) ^ (unsigned)el) << 4)), hi2 = *(const LAS u32x2*)(sl + 4096 + aq0 + (((c0 + 2) ^ (unsigned)el) << 4));
                    u32x4 kv = {lo.x, lo.y, hi2.x, hi2.y};
                    at = __builtin_amdgcn_mfma_f32_16x16x32_bf16(__builtin_bit_cast(bf16x8, kv), qf[ks], at, 0, 0, 0); }
#pragma unroll
                for (int r = 0; r < 4; ++r) at[r] = (4 * g + r <= el) ? at[r] : 0.f;
                const s16x4 vt = hg::trr(slb + 12288 + atr + ((((unsigned)(2 * w) + (unsigned)(pp >> 1)) ^ (unsigned)tk) << 4));
                s16x4 kt[8];
#pragma unroll
                for (int mt = 0; mt < 8; ++mt) kt[mt] = hg::trr(slb + 8192 + atr + ((((unsigned)(2 * mt) + (unsigned)(pp >> 1)) ^ (unsigned)tk) << 4));
                asm volatile("s_waitcnt lgkmcnt(0)" ::: "memory"); __builtin_amdgcn_sched_barrier(0);
                const bf16x8 vfr = {vt[0], vt[1], vt[2], vt[3], 0, 0, 0, 0};
                { u32x4 av = {cvt_pk_bf16(at[0], at[1]), cvt_pk_bf16(at[2], at[3]), 0u, 0u};
                  oacc = __builtin_amdgcn_mfma_f32_16x16x32_bf16(__builtin_bit_cast(bf16x8, av), vfr, oacc, 0, 0, 0); }
#pragma unroll
                for (int mt = 0; mt < 8; ++mt) { const f32x4 e4 = *(const LAS f32x4*)(sl + 20480 + (16 * mt + 4 * g) * 4);
                    const bf16x8 kfr = {kt[mt][0], kt[mt][1], kt[mt][2], kt[mt][3], 0, 0, 0, 0};
                    S[mt] = __builtin_amdgcn_mfma_f32_16x16x32_bf16(kfr, vfr, S[mt] * e4, 0, 0, 0); }
                LAS float* ot = (LAS float*)(lds + hg::OT + (c & 1) * 8192) + (4 * g) * 128 + 16 * w + el;
#pragma unroll
                for (int r = 0; r < 4; ++r) ot[r * 128] = oacc[r];
            }
            if (w >= 4 && c > 0) {
                const int sp = si == 0 ? hg::NSLOT - 1 : si - 1;
                const LAS float* ot = (const LAS float*)(lds + hg::OT + ((c - 1) & 1) * 8192) + ftok * 128 + 8 * el;
                const f32x4 o0 = *(const LAS f32x4*)ot, o1 = *(const LAS f32x4*)(ot + 4);
                const u32x4 gw = *(const LAS u32x4*)(lds + sp * hg::SLOT + 16384 + ftok * 256 + ((el ^ ftok) << 4));
                float ssq = (o0[0] * o0[0] + o0[1] * o0[1]) + (o0[2] * o0[2] + o0[3] * o0[3]) + (o1[0] * o1[0] + o1[1] * o1[1]) + (o1[2] * o1[2] + o1[3] * o1[3]);
                ssq = hg::sum16(ssq); const float rstd = 1.f / sqrtf(ssq * (1.f / 128) + LN_EPS);
                const f32x4 g0 = {bflo(gw.x), bfhi(gw.x), bflo(gw.y), bfhi(gw.y)}, g1 = {bflo(gw.z), bfhi(gw.z), bflo(gw.w), bfhi(gw.w)};
                *(u32x4*)(obase + (size_t)(16 * (c - 1)) * D) = pg8::pack8(o0 * rstd * gn0 * g0, o1 * rstd * gn1 * g1);
            }
            si = si + 1 >= hg::NSLOT ? 0 : si + 1;
        }
#undef HG_DMA
        asm volatile("s_waitcnt vmcnt(0)" ::: "memory");
        { float* sp = a.out + (smp ? O_HGS : O_HGP) + (((size_t)b * HGH + h) * 128 + 4 * g) * 128 + 16 * w + el;
#pragma unroll
          for (int mt = 0; mt < 8; ++mt)
#pragma unroll
              for (int r = 0; r < 4; ++r) sp[(size_t)(16 * mt + r) * 128] = S[mt][r]; }
        asm volatile("s_waitcnt vmcnt(0) lgkmcnt(0)" ::: "memory"); __builtin_amdgcn_s_barrier(); asm volatile("" ::: "memory");
    }
}

constexpr int N_PHASES = 25;
__global__ void __launch_bounds__(512, 2) fwd(Args a) {
    extern __shared__ __attribute__((aligned(16))) unsigned char lds_raw[];
    LAS unsigned char* lds = (LAS unsigned char*)lds_raw;
    const int tid = threadIdx.x;
    const int G = gridDim.x; const int vcu = (G % 8 == 0) ? ((int)blockIdx.x % 8) * (G / 8) + (int)blockIdx.x / 8 : (int)blockIdx.x;
    const int NGW = G * 8;
    for (int u = tid; u < 64; u += 512) ((LAS unsigned*)(lds + LDS_MISC))[u] = 0u;
    __syncthreads();
#if MK_ONE_LAUNCH
    XcdBarrier bar = xcd_barrier_post((unsigned*)(a.ws + WS_CTL) + CW_BAR, (volatile LAS unsigned*)(lds + LDS_MISC + 32));
#define GRID_BAR() xcd_barrier(bar)
#else
#define GRID_BAR() do {} while (0)
#endif
    const int lo = a.ph_lo, hi = a.ph_hi;
#ifndef PHASE_MASK
#define PHASE_MASK 0xFFFF
#endif
#define KIND(n) (((PHASE_MASK) >> (n)) & 1)
#define IN(k) (lo <= (k) && (k) < hi)
#define SEAM(k) do { if (IN(k) && IN((k) + 1)) GRID_BAR(); } while (0)
#define WSP(T, off) ((T*)(wsp_() + (off)))
    auto wsp_ = [&]() -> unsigned char* { unsigned char* p_ = a.ws; asm volatile("" : "+s"(p_)); return p_; };
#define X WSP(float, WS_X)
#define XB WSP(bf16_t, WS_XB)
#define H WSP(bf16_t, WS_H)
#define MIX WSP(bf16_t, WS_MIX)
#define PU WSP(bf16_t, WS_PU)
#define Zb WSP(float, WS_Z)

    if (KIND(0) && IN(0)) { for (int rep = 0; rep < REP_P0; ++rep) p0_prologue(a, lds, vcu, NGW); } SEAM(0);

#pragma unroll
    for (int l = 0; l < 2; ++l) {
        const int pb = 1 + 12 * l;
        const float* lng = a.in[I_LNG] + (size_t)l * 3 * D; const float* lnb = a.in[I_LNB] + (size_t)l * 3 * D;
#pragma unroll
        for (int j = 0; j < 2; ++j) {
            const int p = pb + 7 * j; const int s = 2 * l + j;
            if (KIND(1) && IN(p)) { pg8::Gemm g{(l == 1 && j == 0) ? MIX : XB  , (const bf16_t*)(wsp_() + WS_WGU) + (size_t)s * 2 * FF * D, M, 2 * FF, D}; pg8::StaticOrder S; S.init(M, 2 * FF, G, (int)blockIdx.x);
                pg8::EpiFfnUp E{H}; for (int rep = 0; rep < REP_UP; ++rep) pg8::gemm_phase<pg8::EpiFfnUp, pg8::StaticOrder, true, true>(lds, g, S, E); }
            SEAM(p);
            if (KIND(2) && IN(p + 1)) { pg8::Gemm g{H, (const bf16_t*)(wsp_() + WS_WD) + (size_t)s * D * FF, M, D, FF}; pg8::StaticOrder S; S.init(M, D, G, (int)blockIdx.x);
                const bool first = (l == 0 && j == 0);
                pg8::EpiResid E{first ? a.in[I_XP] : X, first ? a.in[I_XS] : X + (size_t)MP * D, Zb, ALPHA, 0.5f};
                for (int rep = 0; rep < REP_DN; ++rep) pg8::gemm_phase<pg8::EpiResid, pg8::StaticOrder, true, true>(lds, g, S, E); }
            SEAM(p + 1);
            if (KIND(3) && IN(p + 2)) for (int rep = 0; rep < REP_LN; ++rep) ln_phase(Zb, X, XB, lng + (size_t)(2 * j) * D, lnb + (size_t)(2 * j) * D, vcu, NGW);
            SEAM(p + 2);
            if (j == 0) {
                if (l == 0) {
                    if (KIND(4) && IN(pb + 3)) { pg8::Gemm g{XB, (const bf16_t*)(wsp_() + WS_WINE), M, IN_EVEN, D}; pg8::StaticOrder S; S.init(M, IN_EVEN, G, (int)blockIdx.x);
                        pg8::EpiInEven E{(float*)(wsp_() + WS_U), (bf16_t*)(wsp_() + WS_QB), (bf16_t*)(wsp_() + WS_KB), (bf16_t*)(wsp_() + WS_VB), a.out + O_KP, a.out + O_KS, a.out + O_VP, a.out + O_VS};
                        for (int rep = 0; rep < REP_INE; ++rep) pg8::gemm_phase<pg8::EpiInEven, pg8::StaticOrder, true, true>(lds, g, S, E); }
                    SEAM(pb + 3);
                    if (IN(pb + 4)) { if (KIND(5)) for (int rep = 0; rep < REP_ATT; ++rep) attn_phase(a, lds, rep); if (KIND(6)) for (int rep = 0; rep < REP_POOL; ++rep) pool_phase(a, lds); }
                    SEAM(pb + 4);
                } else {
                    if (KIND(7) && IN(pb + 3)) { pg8::Gemm g{XB, (const bf16_t*)(wsp_() + WS_WINO), M, IN_ODD, D}; pg8::StaticOrder S; S.init(M, IN_ODD, G, (int)blockIdx.x);
                        pg8::EpiInOdd E{wsp_(), (const float*)(wsp_() + WS_TAB + TAB_LB)};
                        pg8::gemm_phase<pg8::EpiInOdd, pg8::StaticOrder, true, true>(lds, g, S, E); }
                    SEAM(pb + 3);
                    if (KIND(8) && IN(pb + 4)) for (int rep = 0; rep < REP_HG; ++rep) hgrn_phase(a, lds);
                    SEAM(pb + 4);
                }
                if (KIND(9) && IN(pb + 5)) { pg8::Gemm g{MIX, (const bf16_t*)(wsp_() + (l == 0 ? WS_WOUTE : WS_WOUTO)), M, D, D}; pg8::StaticOrder S; S.init(M, D, G, (int)blockIdx.x);
                    pg8::EpiResid E{X, X + (size_t)MP * D, Zb, ALPHA, 1.0f};
                    pg8::gemm_phase<pg8::EpiResid, pg8::StaticOrder, true, true>(lds, g, S, E); }
                SEAM(pb + 5);
                if (KIND(3) && IN(pb + 6)) for (int rep = 0; rep < REP_LN; ++rep) ln_phase(Zb, X, XB, lng + (size_t)1 * D, lnb + (size_t)1 * D, vcu, NGW);
                SEAM(pb + 6);
            }
        }
        if (KIND(10) && IN(pb + 10)) { pg8::Gemm g{(const bf16_t*)(wsp_() + WS_PB) + (size_t)l * M * PLE, (const bf16_t*)(wsp_() + WS_WPU) + (size_t)l * D * PLE, M, D, PLE}; pg8::StaticOrder S; S.init(M, D, G, (int)blockIdx.x);
            pg8::EpiBf16 E{PU, D}; pg8::gemm_phase<pg8::EpiBf16, pg8::StaticOrder, true, true>(lds, g, S, E); }
        SEAM(pb + 10);
        if (KIND(11) && IN(pb + 11)) { pg8::Gemm g{XB, (const bf16_t*)(wsp_() + WS_WPG) + (size_t)l * D * D, M, D, D}; pg8::StaticOrder S; S.init(M, D, G, (int)blockIdx.x);
            pg8::EpiPle E{X, MIX, PU, a.out + O_YP, a.out + O_YS, l == 1 ? 1 : 0};
            pg8::gemm_phase<pg8::EpiPle, pg8::StaticOrder, true, true>(lds, g, S, E); }
        SEAM(pb + 11);
    }
#undef IN
#undef SEAM
#undef X
#undef XB
#undef H
#undef MIX
#undef PU
#undef Zb
#undef WSP
}

extern "C" void kernel_launch(void* const* d_in, const int* in_sizes, int n_in, void* d_out, int out_size, void* d_ws, size_t ws_size, hipStream_t stream) {
    static int grid = 0;
    if (grid == 0) {
        if (n_in != 29 || (size_t)out_size != O_END || ws_size < WS_END) { fprintf(stderr, "kernel_launch: shape mismatch: n_in %d out %d (want %zu) ws %zu (want >= %zu)\n", n_in, out_size, (size_t)O_END, ws_size, (size_t)WS_END); grid = -1; return; }
        int dev = 0, cus = 0, per_cu = 0;
        if (hipGetDevice(&dev) != hipSuccess || hipDeviceGetAttribute(&cus, hipDeviceAttributeMultiprocessorCount, dev) != hipSuccess) { fprintf(stderr, "kernel_launch: device query failed\n"); grid = -1; return; }
        if (hipFuncSetAttribute((const void*)fwd, hipFuncAttributeMaxDynamicSharedMemorySize, LDS_BYTES) != hipSuccess) { fprintf(stderr, "kernel_launch: hipFuncSetAttribute failed\n"); grid = -1; return; }
        if (hipOccupancyMaxActiveBlocksPerMultiprocessor(&per_cu, (const void*)fwd, 512, LDS_BYTES) != hipSuccess || per_cu < 1) fprintf(stderr, "kernel_launch: occupancy query reports %d blocks per CU\n", per_cu);
        (void)hipGetLastError();
        grid = cus;
    }
    if (grid < 0) return;
    if (hipMemsetAsync((char*)d_ws + WS_CTL, 0, CTL_ZERO_BYTES, stream) != hipSuccess) { fprintf(stderr, "kernel_launch: memset failed\n"); return; }
    Args a{};
    for (int i = 0; i < 29; ++i) a.in[i] = (const float*)d_in[i];
    a.out = (float*)d_out; a.ws = (unsigned char*)d_ws;
#if MK_ONE_LAUNCH
    a.ph_lo = 0; a.ph_hi = N_PHASES;
    hipLaunchKernelGGL(fwd, dim3(grid), dim3(512), LDS_BYTES, stream, a);
#else
    for (int p = 0; p < N_PHASES; ++p) { a.ph_lo = p; a.ph_hi = p + 1; hipLaunchKernelGGL(fwd, dim3(grid), dim3(512), LDS_BYTES, stream, a); }
#endif
    const hipError_t le = hipPeekAtLastError();
    if (le != hipSuccess) fprintf(stderr, "kernel_launch: launch failed: %s\n", hipGetErrorName(le));
}
```

```cpp
#include <hip/hip_runtime.h>
#include <cstdio>
#include <cstdint>

#ifndef MK_ONE_LAUNCH
#define MK_ONE_LAUNCH 1
#endif

#ifndef REP_P0
#define REP_P0 1
#endif
#ifndef REP_UP
#define REP_UP 1
#endif
#ifndef REP_ATT
#define REP_ATT 1
#endif
#ifndef REP_POOL
#define REP_POOL 1
#endif
#ifndef REP_HG
#define REP_HG 1
#endif
#ifndef REP_LN
#define REP_LN 1
#endif
#ifndef REP_DN
#define REP_DN 1
#endif
#ifndef REP_INE
#define REP_INE 1
#endif
#define LAS __attribute__((address_space(3)))
#define GAS __attribute__((address_space(1)))
typedef unsigned short bf16_t;
typedef short bf16x8 __attribute__((ext_vector_type(8)));
typedef short s16x4 __attribute__((ext_vector_type(4)));
typedef float f32x2 __attribute__((ext_vector_type(2)));
typedef float f32x4 __attribute__((ext_vector_type(4)));
typedef float f32x16 __attribute__((ext_vector_type(16)));
typedef unsigned u32x2 __attribute__((ext_vector_type(2)));
typedef unsigned u32x4 __attribute__((ext_vector_type(4)));

constexpr int D = 2048, FF = 5632, MP = 32768, MS = 2048, M = MP + MS, SEQ = 2048, DSEQ = 64, NB_P = 16, NB_S = 32, PAST = 2048;
constexpr int PLE = 256, POOLW = 512, DAW = 1536, NH = 12, HD = 128, IN_EVEN = 5120, IN_ODD = 8192, HGH = 16;
constexpr float ALPHA = 1.4142135623730951f, LN_EPS = 1e-5f, LOG2E = 1.4426950408889634f;
constexpr float QSCALE = 0.125f * LOG2E;
constexpr float LAM_INIT = 0.2f;

constexpr size_t MiB = 1u << 20;
constexpr size_t WS_CTL = 0, CTL_ZERO_BYTES = 4 * MiB;
constexpr size_t WS_STATS = 1 * MiB;
constexpr size_t WS_C12 = 3 * MiB;
constexpr int C_INE = 0, C_INO = C_INE + 2 * 5120, C_UP0 = C_INO + 2 * 8192, C_UP1 = C_UP0 + 2 * 11264, C_PG0 = C_UP1 + 2 * 11264, C_PG1 = C_PG0 + 2 * 2048, C_END = C_PG1 + 2 * 2048;
static_assert(WS_STATS + (size_t)6 * 34816 * 2 * 4 <= WS_C12 && WS_C12 + (size_t)C_END * 4 <= CTL_ZERO_BYTES, "CTL map");
constexpr size_t WS_TAB = 4 * MiB;
constexpr size_t TAB_BIAS = 0;
constexpr size_t TAB_LB = 16384;
constexpr size_t TAB_PWT = 65536;
constexpr size_t WS_WGU = 5 * MiB;
constexpr size_t WS_WD = WS_WGU + 176 * MiB;
constexpr size_t WS_WINE = WS_WD + 88 * MiB;
constexpr size_t WS_WOUTE = WS_WINE + 20 * MiB;
constexpr size_t WS_WINO = WS_WOUTE + 8 * MiB;
constexpr size_t WS_WOUTO = WS_WINO + 32 * MiB;
constexpr size_t WS_WPG = WS_WOUTO + 8 * MiB;
constexpr size_t WS_WPU = WS_WPG + 16 * MiB;
constexpr size_t WS_X = WS_WPU + 2 * MiB;
constexpr size_t WS_XB = WS_X + 272 * MiB;
constexpr size_t WS_PB = WS_XB + 136 * MiB;
constexpr size_t WS_R = WS_PB + 34 * MiB;
constexpr size_t WS_H = WS_R;
constexpr size_t WS_PU = WS_R;
constexpr size_t WS_U = WS_R;
constexpr size_t WS_QB = WS_U + 68 * MiB;
constexpr size_t WS_KB = WS_QB + 102 * MiB;
constexpr size_t WS_VB = WS_KB + 96 * MiB;
constexpr size_t WS_MIX = WS_R + 816 * MiB;
constexpr size_t WS_QE = WS_R;
constexpr size_t WS_KI = WS_QE + 136 * MiB;
constexpr size_t WS_VV = WS_KI + 136 * MiB;
constexpr size_t WS_GG = WS_VV + 136 * MiB;
constexpr size_t WS_KD = WS_GG + 136 * MiB;
constexpr size_t WS_EB = WS_KD + 136 * MiB;
static_assert(WS_EB + 17 * MiB <= WS_MIX && WS_VB + 96 * MiB <= WS_MIX && WS_H + 374 * MiB <= WS_MIX, "overlay map");
constexpr size_t WS_XB2 = WS_R + 374 * MiB;
constexpr size_t WS_END = WS_MIX + 136 * MiB;

constexpr int CW_BAR = 4096;
constexpr int CW_QATT = 64;

constexpr int LDS_BYTES = 147456;
constexpr int LDS_ATAB = 131072;
constexpr int LDS_MISC = 139264;

__device__ __forceinline__ unsigned cvt_pk_bf16(float lo, float hi) { unsigned r; asm volatile("v_cvt_pk_bf16_f32 %0, %1, %2" : "=v"(r) : "v"(lo), "v"(hi)); return r; }
__device__ __forceinline__ float bf2f(unsigned short b) { return __builtin_bit_cast(float, (unsigned)b << 16); }
__device__ __forceinline__ float bflo(unsigned w) { return __builtin_bit_cast(float, w << 16); }
__device__ __forceinline__ float bfhi(unsigned w) { return __builtin_bit_cast(float, w & 0xffff0000u); }
__device__ __forceinline__ float fast_exp2(float x) { return __builtin_amdgcn_exp2f(x); }
__device__ __forceinline__ float fast_rcp(float x) { return __builtin_amdgcn_rcpf(x); }
__device__ __forceinline__ float sigmoidf_(float x) { return fast_rcp(1.f + fast_exp2(-x * LOG2E)); }
__device__ __forceinline__ float wave_sum(float v) {
#pragma unroll
    for (int o = 1; o < 64; o <<= 1) v += __shfl_xor(v, o);
    return v;
}
#define LDS_WAIT() asm volatile("s_waitcnt lgkmcnt(0)" ::: "memory")
#define VM_WAIT() asm volatile("s_waitcnt vmcnt(0)" ::: "memory")

namespace pg8 {
constexpr int BM = 256, BK = 64, HALF = 128, HTB = HALF * BK * 2, STAGE_BYTES = 8 * HTB, NXCD = 8, WGM = 8;
__host__ __device__ __forceinline__ int lds_byte(int r, int c) { const int st = (r >> 4) * 2 + (c >> 5), rr = r & 15, cc = c & 31, ob = rr * 64 + cc * 2; return st * 1024 + (ob ^ (((ob >> 9) & 1) << 5)); }
__host__ __device__ __forceinline__ void stage_rc(int b, int& R, int& C) { const int st = b / 1024, sb = b % 1024, swz = sb ^ (((sb >> 9) & 1) << 5); R = (st >> 1) * 16 + swz / 64; C = (st & 1) * 32 + (swz % 64) / 2; }
__host__ __device__ __forceinline__ int perm32(int rho) { const int n = rho >> 4, i = rho & 15; return 8 * (i >> 2) + 4 * n + (i & 3); }
struct Unit { int pm, pn; };
struct Gemm { const bf16_t* A; const bf16_t* Bt; int M, N, K; };
struct StaticOrder {
    int nM, nN, nwg, G, c;
    __host__ __device__ void init(int M_, int N_, int G_, int c_) { nM = M_ / BM; nN = N_ / BM; nwg = nM * nN; G = G_; c = c_; }
    __host__ __device__ bool next(int i, Unit& u) const {
        const long L = (long)i * G + c; if (L >= nwg) return false;
        int wgid = (int)L; { const int q = nwg / NXCD, r = nwg % NXCD, xcd = wgid % NXCD, off = wgid / NXCD; wgid = (xcd < r ? xcd * (q + 1) : r * (q + 1) + (xcd - r) * q) + off; }
        const int nig = WGM * nN, gid = wgid / nig, fm = gid * WGM, gsz = (nM - fm) < WGM ? (nM - fm) : WGM;
        u.pm = fm + ((wgid % nig) % gsz); u.pn = (wgid % nig) / gsz; return true;
    }
    __device__ __forceinline__ void a_ready(const Unit&) const {}
    __device__ __forceinline__ void done(const Unit&) const {}
};

template <class Epi, class Sched, bool ALIGN_EPI = false, bool SP2 = false>
__device__ __forceinline__ void gemm_phase(LAS unsigned char* lds, const Gemm g, const Sched& S, const Epi& E) {
    int tid = threadIdx.x; asm volatile("" : "+v"(tid));
    const int wid = __builtin_amdgcn_readfirstlane(tid >> 6), lane = tid & 63, wr = wid >> 2, wc = wid & 3, fr = lane & 15, fq = lane >> 4;
    int K = g.K; asm volatile("" : "+s"(K));
    const int nt = K / BK;
    unsigned voffA[2], voffB[2];
#pragma unroll
    for (int i = 0; i < 2; ++i) { int R, C; stage_rc(tid * 16 + i * 8192, R, C); const int Rb = Epi::PERM ? ((R & ~31) + perm32(R & 31)) : R;
        voffA[i] = (unsigned)(R * K + C) * 2u; voffB[i] = (unsigned)(Rb * K + C) * 2u; }
    const size_t kstep = (size_t)(BK * 2);
    const size_t hstep = (size_t)HALF * K * 2;
    const size_t tstep = 2 * hstep;
    const unsigned ldsw = (unsigned)wid * 1024u;
    const int aoff = lds_byte(wr * 64 + fr, fq * 8), boff = lds_byte(wc * 32 + fr, fq * 8);
#define PG8_SA(b, h) (((b) * 2 + (h)) * HTB)
#define PG8_SB(b, h) ((4 + (b) * 2 + (h)) * HTB)
#define PG8_STAGE(bufoff, gbase, voff) do { _Pragma("unroll") for (int _i = 0; _i < 2; ++_i) \
        __builtin_amdgcn_global_load_lds((const unsigned*)((const char*)(gbase) + (voff)[_i]), (LAS unsigned*)(lds + (bufoff) + ldsw + _i * 8192), 16, 0, 0); } while (0)
#define PG8_LDA(dst, b, h) do { _Pragma("unroll") for (int m = 0; m < 4; ++m) _Pragma("unroll") for (int k = 0; k < 2; ++k) dst[m][k] = *(const LAS bf16x8*)(lds + PG8_SA(b, h) + aoff + m * 2048 + k * 1024); } while (0)
#define PG8_LDB(dst, b, h) do { _Pragma("unroll") for (int n = 0; n < 2; ++n) _Pragma("unroll") for (int k = 0; k < 2; ++k) dst[n][k] = *(const LAS bf16x8*)(lds + PG8_SB(b, h) + boff + n * 2048 + k * 1024); } while (0)
#define PG8_MMA(ai, bj, At, Bt) do { __builtin_amdgcn_s_setprio(1); _Pragma("unroll") for (int m = 0; m < 4; ++m) _Pragma("unroll") for (int n = 0; n < 2; ++n) _Pragma("unroll") for (int k = 0; k < 2; ++k) \
        acc[ai][bj][m][n] = __builtin_amdgcn_mfma_f32_16x16x32_bf16(Bt[n][k], At[m][k], acc[ai][bj][m][n], 0, 0, 0); __builtin_amdgcn_s_setprio(0); } while (0)
#define PG8_WAIT_V(n) asm volatile("s_waitcnt vmcnt(" #n ")" ::: "memory")
#define PG8_WAIT_L(n) asm volatile("s_waitcnt lgkmcnt(" #n ")" ::: "memory")
#define PG8_BAR __builtin_amdgcn_s_barrier()
#define PG8_SCHED __builtin_amdgcn_sched_barrier(0)
    Unit cur, nxt; int ui = 0;
    if (!S.next(0, cur)) return;
    f32x4 acc[2][2][4][2];
#pragma unroll
    for (int a = 0; a < 2; ++a)
#pragma unroll
        for (int b = 0; b < 2; ++b)
#pragma unroll
            for (int m = 0; m < 4; ++m)
#pragma unroll
                for (int n = 0; n < 2; ++n) acc[a][b][m][n] = (f32x4){0.f, 0.f, 0.f, 0.f};
    bf16x8 At[4][2], B0[2][2], B1[2][2];
    const char* cA = (const char*)g.A + (size_t)cur.pm * tstep; const char* cB = (const char*)g.Bt + (size_t)cur.pn * tstep;
    S.a_ready(cur);
    if constexpr (SP2) {
        PG8_STAGE(PG8_SB(0, 0), cB, voffB); PG8_STAGE(PG8_SB(0, 1), cB + hstep, voffB); PG8_STAGE(PG8_SA(0, 0), cA, voffA); PG8_STAGE(PG8_SA(0, 1), cA + hstep, voffA);
        if (wr == 1) PG8_BAR;
        PG8_WAIT_V(2); PG8_BAR;
        PG8_STAGE(PG8_SB(1, 0), cB + kstep, voffB); PG8_STAGE(PG8_SA(1, 0), cA + kstep, voffA); PG8_STAGE(PG8_SB(1, 1), cB + hstep + kstep, voffB);
        PG8_WAIT_V(6); PG8_BAR;
    } else {
        PG8_STAGE(PG8_SB(0, 0), cB, voffB); PG8_STAGE(PG8_SA(0, 0), cA, voffA); PG8_STAGE(PG8_SB(0, 1), cB + hstep, voffB); PG8_STAGE(PG8_SA(0, 1), cA + hstep, voffA);
        if (wr == 1) PG8_BAR;
        PG8_WAIT_V(4); PG8_BAR;
        PG8_STAGE(PG8_SB(1, 0), cB + kstep, voffB); PG8_STAGE(PG8_SA(1, 0), cA + kstep, voffA); PG8_STAGE(PG8_SB(1, 1), cB + hstep + kstep, voffB);
        PG8_WAIT_V(6); PG8_BAR;
    }
    for (;;) {
        const bool has_next = S.next(ui + 1, nxt);
        const char* nA = has_next ? (const char*)g.A + (size_t)nxt.pm * tstep : cA; const char* nB = has_next ? (const char*)g.Bt + (size_t)nxt.pn * tstep : cB;
        for (int t = 0; t < nt; t += 2) {
            const bool last = (t == nt - 2);
            const char* a1 = cA + (size_t)(t + 1) * kstep;
            const char* a2 = last ? nA : cA + (size_t)(t + 2) * kstep; const char* b2 = last ? nB : cB + (size_t)(t + 2) * kstep;
            const char* a3 = a2 + kstep; const char* b3 = b2 + kstep;
            if (last && has_next) S.a_ready(nxt);
            if constexpr (SP2) {
            PG8_LDB(B0, 0, 0); PG8_LDB(B1, 0, 1); PG8_SCHED; PG8_LDA(At, 0, 0); PG8_STAGE(PG8_SA(1, 1), a1 + hstep, voffA);
            PG8_WAIT_V(8); PG8_WAIT_L(0); PG8_BAR; PG8_MMA(0, 0, At, B0); PG8_MMA(0, 1, At, B1); PG8_BAR; PG8_SCHED;
            PG8_LDA(At, 0, 1); PG8_STAGE(PG8_SB(0, 0), b2, voffB); PG8_STAGE(PG8_SB(0, 1), b2 + hstep, voffB); PG8_STAGE(PG8_SA(0, 0), a2, voffA);
            PG8_WAIT_V(8); PG8_WAIT_L(0); PG8_BAR; PG8_MMA(1, 0, At, B0); PG8_MMA(1, 1, At, B1); PG8_BAR; PG8_SCHED;
            PG8_LDB(B0, 1, 0); PG8_LDB(B1, 1, 1); PG8_SCHED; PG8_LDA(At, 1, 0); PG8_STAGE(PG8_SA(0, 1), a2 + hstep, voffA);
            PG8_WAIT_V(8); PG8_WAIT_L(0); PG8_BAR; PG8_MMA(0, 0, At, B0); PG8_MMA(0, 1, At, B1); PG8_BAR; PG8_SCHED;
            PG8_LDA(At, 1, 1); PG8_STAGE(PG8_SB(1, 0), b3, voffB); PG8_STAGE(PG8_SB(1, 1), b3 + hstep, voffB); PG8_STAGE(PG8_SA(1, 0), a3, voffA);
            PG8_WAIT_V(8); PG8_WAIT_L(0); PG8_BAR; PG8_MMA(1, 0, At, B0); PG8_MMA(1, 1, At, B1); PG8_BAR; PG8_SCHED;
            } else {
            PG8_LDB(B0, 0, 0); PG8_SCHED; PG8_LDA(At, 0, 0); PG8_STAGE(PG8_SA(1, 1), a1 + hstep, voffA);
            PG8_WAIT_L(8); PG8_BAR; PG8_WAIT_L(0); PG8_MMA(0, 0, At, B0); PG8_BAR; PG8_SCHED;
            PG8_LDB(B1, 0, 1); PG8_STAGE(PG8_SB(0, 0), b2, voffB);
            PG8_BAR; PG8_WAIT_L(0); PG8_MMA(0, 1, At, B1); PG8_BAR;
            PG8_LDA(At, 0, 1); PG8_STAGE(PG8_SA(0, 0), a2, voffA);
            PG8_BAR; PG8_WAIT_L(0); PG8_MMA(1, 0, At, B0); PG8_BAR; PG8_SCHED;
            PG8_STAGE(PG8_SB(0, 1), b2 + hstep, voffB);
            PG8_WAIT_V(6); PG8_BAR; PG8_MMA(1, 1, At, B1); PG8_BAR;
            PG8_LDB(B0, 1, 0); PG8_SCHED; PG8_LDA(At, 1, 0); PG8_STAGE(PG8_SA(0, 1), a2 + hstep, voffA);
            PG8_WAIT_L(8); PG8_BAR; PG8_WAIT_L(0); PG8_MMA(0, 0, At, B0); PG8_BAR; PG8_SCHED;
            PG8_LDB(B1, 1, 1); PG8_STAGE(PG8_SB(1, 0), b3, voffB);
            PG8_BAR; PG8_WAIT_L(0); PG8_MMA(0, 1, At, B1); PG8_BAR;
            PG8_LDA(At, 1, 1); PG8_STAGE(PG8_SA(1, 0), a3, voffA);
            PG8_BAR; PG8_WAIT_L(0); PG8_MMA(1, 0, At, B0); PG8_BAR; PG8_SCHED;
            PG8_STAGE(PG8_SB(1, 1), b3 + hstep, voffB);
            PG8_WAIT_V(6); PG8_BAR; PG8_MMA(1, 1, At, B1); PG8_BAR;
            }
        }
        if constexpr (ALIGN_EPI) { if (wr == 0) PG8_BAR; }
        E(acc, cur, wr, wc, fr, fq); S.done(cur);
        if (!has_next) break;
#pragma unroll
        for (int a = 0; a < 2; ++a)
#pragma unroll
            for (int b = 0; b < 2; ++b)
#pragma unroll
                for (int m = 0; m < 4; ++m)
#pragma unroll
                    for (int n = 0; n < 2; ++n) acc[a][b][m][n] = (f32x4){0.f, 0.f, 0.f, 0.f};
        cur = nxt; cA = nA; cB = nB; ++ui;
        if constexpr (ALIGN_EPI) { if (wr == 1) PG8_BAR; }
    }
    PG8_WAIT_V(0);
    if constexpr (!ALIGN_EPI) { if (wr == 0) PG8_BAR; }
    PG8_BAR;
#undef PG8_SA
#undef PG8_SB
#undef PG8_STAGE
#undef PG8_LDA
#undef PG8_LDB
#undef PG8_MMA
#undef PG8_WAIT_V
#undef PG8_WAIT_L
#undef PG8_BAR
#undef PG8_SCHED
}

typedef const f32x4 (&AccRef)[2][2][4][2];
__device__ __forceinline__ u32x4 pack8(f32x4 a, f32x4 b) { u32x4 w; w.x = cvt_pk_bf16(a[0], a[1]); w.y = cvt_pk_bf16(a[2], a[3]); w.z = cvt_pk_bf16(b[0], b[1]); w.w = cvt_pk_bf16(b[2], b[3]); return w; }
__device__ __forceinline__ f32x4 silu4(f32x4 g) { f32x4 r;
#pragma unroll
    for (int i = 0; i < 4; ++i) r[i] = g[i] * fast_rcp(1.f + fast_exp2(-g[i] * LOG2E));
    return r; }

__device__ __forceinline__ void ln_row(const float* st, int row, float& rstd, float& t  , float& mu) {
    const f32x2 sv = *(const f32x2*)(st + 2 * (size_t)row); mu = sv.x * (1.f / D); const float var = sv.y * (1.f / D) - mu * mu; rstd = __builtin_amdgcn_rsqf(var + LN_EPS); t = mu * rstd; }
__device__ __forceinline__ f32x4 fold4(f32x4 acc, float rstd, float t, f32x4 c1, f32x4 c2) { return acc * rstd + (c2 - c1 * t); }

struct EpiFfnUp { static constexpr bool PERM = true;
    bf16_t* H; const float* st; const float* cv;
    __device__ __forceinline__ void operator()(AccRef acc, const Unit& u, int wr, int wc, int fr, int fq) const {
        const int row0 = u.pm * BM + wr * 64 + fr, col0 = u.pn * HALF + wc * 32 + 8 * fq, ct = u.pn * BM + wc * 32 + 8 * fq;
        f32x4 c1g[2], c1u[2], c2g[2], c2u[2];
        if (st) {
#pragma unroll
            for (int n = 0; n < 2; ++n) { c1g[n] = *(const f32x4*)(cv + ct + 4 * n); c1u[n] = *(const f32x4*)(cv + ct + HALF + 4 * n); c2g[n] = *(const f32x4*)(cv + 2 * FF + ct + 4 * n); c2u[n] = *(const f32x4*)(cv + 2 * FF + ct + HALF + 4 * n); } }
#pragma unroll
        for (int ai = 0; ai < 2; ++ai)
#pragma unroll
            for (int m = 0; m < 4; ++m) { const int row = row0 + ai * HALF + m * 16; bf16_t* p = H + (size_t)row * FF + col0;
                f32x4 g0 = acc[ai][0][m][0], g1 = acc[ai][0][m][1], u0 = acc[ai][1][m][0], u1 = acc[ai][1][m][1];
                if (st) { float rstd, t, mu; ln_row(st, row, rstd, t, mu); g0 = fold4(g0, rstd, t, c1g[0], c2g[0]); g1 = fold4(g1, rstd, t, c1g[1], c2g[1]); u0 = fold4(u0, rstd, t, c1u[0], c2u[0]); u1 = fold4(u1, rstd, t, c1u[1], c2u[1]); }
                *(u32x4*)p = pack8(silu4(g0) * u0, silu4(g1) * u1); }
    }
};
struct EpiResid { static constexpr bool PERM = true;
    const float* xs0; const float* xs1; float* Z; bf16_t* ZB; const float* si; const float* gi; const float* bi; float* so; float alpha, beta;
    __device__ __forceinline__ void operator()(AccRef acc, const Unit& u, int wr, int wc, int fr, int fq) const {
        const int row0 = u.pm * BM + wr * 64 + fr, col0 = u.pn * BM + wc * 32 + 8 * fq;
        const float* xs = (u.pm < MP / BM) ? xs0 : xs1 - (size_t)MP * D;
        f32x4 gv[2][2], bv[2][2];
#pragma unroll
        for (int bj = 0; bj < 2; ++bj)
#pragma unroll
            for (int n = 0; n < 2; ++n) { gv[bj][n] = (f32x4){1.f, 1.f, 1.f, 1.f}; bv[bj][n] = (f32x4){0.f, 0.f, 0.f, 0.f};
                if (si) { gv[bj][n] = *(const f32x4*)(gi + col0 + bj * HALF + 4 * n); bv[bj][n] = *(const f32x4*)(bi + col0 + bj * HALF + 4 * n); } }
#pragma unroll
        for (int ai = 0; ai < 2; ++ai)
#pragma unroll
            for (int m = 0; m < 4; ++m) { const int row = row0 + ai * HALF + m * 16; const size_t off = (size_t)row * D + col0;
                float rstd = 1.f, t = 0.f, mu = 0.f; if (si) ln_row(si, row, rstd, t, mu);
                float s1 = 0.f, s2 = 0.f;
#pragma unroll
                for (int bj = 0; bj < 2; ++bj) { f32x4 x0 = *(const f32x4*)(xs + off + bj * HALF), x1 = *(const f32x4*)(xs + off + bj * HALF + 4);
                    if (si) { x0 = (x0 * rstd - t) * gv[bj][0] + bv[bj][0]; x1 = (x1 * rstd - t) * gv[bj][1] + bv[bj][1]; }
                    const f32x4 z0 = x0 * alpha + acc[ai][bj][m][0] * beta, z1 = x1 * alpha + acc[ai][bj][m][1] * beta;
                    *(f32x4*)(Z + off + bj * HALF) = z0; *(f32x4*)(Z + off + bj * HALF + 4) = z1; *(u32x4*)(ZB + off + bj * HALF) = pack8(z0, z1);
                    s1 += (z0[0] + z0[1]) + (z0[2] + z0[3]) + (z1[0] + z1[1]) + (z1[2] + z1[3]);
                    s2 += (z0[0] * z0[0] + z0[1] * z0[1]) + (z0[2] * z0[2] + z0[3] * z0[3]) + (z1[0] * z1[0] + z1[1] * z1[1]) + (z1[2] * z1[2] + z1[3] * z1[3]); }
                s1 += __shfl_xor(s1, 16); s2 += __shfl_xor(s2, 16); s1 += __shfl_xor(s1, 32); s2 += __shfl_xor(s2, 32);
                if (fq == 0) { unsafeAtomicAdd(so + 2 * (size_t)row, s1); unsafeAtomicAdd(so + 2 * (size_t)row + 1, s2); }
                if (m & 1) __builtin_amdgcn_sched_barrier(0); }
    }
};
struct EpiInEven { static constexpr bool PERM = true;
    float* U; bf16_t* QB; bf16_t* KB; bf16_t* VB; float* nk0; float* nk1; float* nv0; float* nv1; const float* st; const float* cv;
    __device__ __forceinline__ void operator()(AccRef acc, const Unit& u, int wr, int wc, int fr, int fq) const {
        const int row0 = u.pm * BM + wr * 64 + fr, cin = wc * 32 + 8 * fq, ct = u.pn * BM + cin; const bool prompt = u.pm < MP / BM;
        f32x4 c1[2][2], c2[2][2];
#pragma unroll
        for (int bj = 0; bj < 2; ++bj)
#pragma unroll
            for (int n = 0; n < 2; ++n) { c1[bj][n] = *(const f32x4*)(cv + ct + bj * HALF + 4 * n); c2[bj][n] = *(const f32x4*)(cv + IN_EVEN + ct + bj * HALF + 4 * n); }
        const int kind = u.pn < 2 ? 0 : u.pn < 8 ? 1 : u.pn < 14 ? 2 : 3; const int col0 = (u.pn - (kind == 0 ? 0 : kind == 1 ? 2 : kind == 2 ? 8 : 14)) * BM + cin;
        float* o32 = kind == 2 ? (prompt ? nk0 : nk1 - (size_t)MP * DAW) : (prompt ? nv0 : nv1 - (size_t)MP * DAW); bf16_t* o16 = kind == 2 ? KB : VB;
#pragma unroll
        for (int ai = 0; ai < 2; ++ai)
#pragma unroll
            for (int m = 0; m < 4; ++m) { const int row = row0 + ai * HALF + m * 16; float rstd, t, mu; ln_row(st, row, rstd, t, mu);
#pragma unroll
                for (int bj = 0; bj < 2; ++bj) { const f32x4 v0 = fold4(acc[ai][bj][m][0], rstd, t, c1[bj][0], c2[bj][0]), v1 = fold4(acc[ai][bj][m][1], rstd, t, c1[bj][1], c2[bj][1]);
                    if (kind == 0) { float* p = U + (size_t)row * POOLW + col0 + bj * HALF; *(f32x4*)p = v0; *(f32x4*)(p + 4) = v1; }
                    else if (kind == 1) { *(u32x4*)(QB + (size_t)row * DAW + col0 + bj * HALF) = pack8(v0 * QSCALE, v1 * QSCALE); }
                    else { const size_t off = (size_t)row * DAW + col0 + bj * HALF; *(f32x4*)(o32 + off) = v0; *(f32x4*)(o32 + off + 4) = v1; if (prompt) *(u32x4*)(o16 + off) = pack8(v0, v1); } } }
    }
};
__device__ __forceinline__ float scan16(float x) {
#define DPP_SHR(v, n) __builtin_bit_cast(float, __builtin_amdgcn_update_dpp(0, __builtin_bit_cast(int, v), 0x110 + (n), 0xf, 0xf, true))
    x += DPP_SHR(x, 1); x += DPP_SHR(x, 2); x += DPP_SHR(x, 4); x += DPP_SHR(x, 8);
#undef DPP_SHR
    return x; }
struct EpiInOdd { static constexpr bool PERM = true;
    unsigned char* wsb; const float* lbv; const float* st; const float* cv;
    __device__ __forceinline__ void operator()(AccRef acc, const Unit& u, int wr, int wc, int fr, int fq) const {
        const int row0 = u.pm * BM + wr * 64 + fr, cb = (u.pn >> 1) * HALF + wc * 32 + 8 * fq, ct = u.pn * BM + wc * 32 + 8 * fq;
#define AT(T, base, boff) ((T*)(wsb + (size_t)(unsigned)((base) + (boff))))
        f32x4 c1[2][2], c2[2][2];
#pragma unroll
        for (int bj = 0; bj < 2; ++bj)
#pragma unroll
            for (int n = 0; n < 2; ++n) { c1[bj][n] = *(const f32x4*)(cv + ct + bj * HALF + 4 * n); c2[bj][n] = *(const f32x4*)(cv + IN_ODD + ct + bj * HALF + 4 * n); }
        if ((u.pn & 1) == 0) {
            const f32x4 lb0 = *(const f32x4*)(lbv + cb), lb1 = *(const f32x4*)(lbv + cb + 4);
            const int l15 = (int)((threadIdx.x & 48u) | 15u);
#pragma unroll
            for (int ai = 0; ai < 2; ++ai)
#pragma unroll
                for (int m = 0; m < 4; ++m) { const int row = row0 + ai * HALF + m * 16; const unsigned off = ((unsigned)row * D + cb) * 2u;
                    float rstd, t, mu; ln_row(st, row, rstd, t, mu);
                    f32x4 qe[2], ki[2], kd[2]; float* e = AT(float, (unsigned)WS_EB, ((unsigned)(row >> 4) * D + cb) * 4u);
#pragma unroll
                    for (int n = 0; n < 2; ++n) { const f32x4 qv = fold4(acc[ai][0][m][n], rstd, t, c1[0][n], c2[0][n]), zv = fold4(acc[ai][1][m][n], rstd, t, c1[1][n], c2[1][n]);
#pragma unroll
                        for (int i = 0; i < 4; ++i) { const float q = qv[i], z = zv[i], lb = n ? lb1[i] : lb0[i];
                            const float sg = fast_rcp(1.f + fast_exp2(-z * LOG2E)); const float f = lb + (1.f - lb) * sg, kk = (1.f - lb) * (1.f - sg);
                            const float b = scan16(__builtin_amdgcn_logf(f)); const float bl = __shfl(b, l15, 64);
                            qe[n][i] = q * fast_rcp(1.f + fast_exp2(-q * LOG2E)) * fast_exp2(b); ki[n][i] = kk * fast_exp2(-b); kd[n][i] = kk * fast_exp2(bl - b);
                            if (fr == 15) e[4 * n + i] = fast_exp2(b); } }
                    *AT(u32x4, (unsigned)WS_QE, off) = pack8(qe[0], qe[1]); *AT(u32x4, (unsigned)WS_KI, off) = pack8(ki[0], ki[1]); *AT(u32x4, (unsigned)WS_KD, off) = pack8(kd[0], kd[1]);
                    __builtin_amdgcn_sched_barrier(0); }
        } else {
#pragma unroll
            for (int ai = 0; ai < 2; ++ai)
#pragma unroll
                for (int m = 0; m < 4; ++m) { const int row = row0 + ai * HALF + m * 16; const unsigned off = ((unsigned)row * D + cb) * 2u; float rstd, t, mu; ln_row(st, row, rstd, t, mu);
                    *AT(u32x4, (unsigned)WS_VV, off) = pack8(fold4(acc[ai][0][m][0], rstd, t, c1[0][0], c2[0][0]), fold4(acc[ai][0][m][1], rstd, t, c1[0][1], c2[0][1]));
                    *AT(u32x4, (unsigned)WS_GG, off) = pack8(silu4(fold4(acc[ai][1][m][0], rstd, t, c1[1][0], c2[1][0])), silu4(fold4(acc[ai][1][m][1], rstd, t, c1[1][1], c2[1][1]))); }
        }
#undef AT
    }
};
struct EpiBf16 { static constexpr bool PERM = true;
    bf16_t* O; int ldc;
    __device__ __forceinline__ void operator()(AccRef acc, const Unit& u, int wr, int wc, int fr, int fq) const {
        const int row0 = u.pm * BM + wr * 64 + fr, col0 = u.pn * BM + wc * 32 + 8 * fq;
#pragma unroll
        for (int ai = 0; ai < 2; ++ai)
#pragma unroll
            for (int m = 0; m < 4; ++m) { bf16_t* p = O + (size_t)(row0 + ai * HALF + m * 16) * ldc + col0;
#pragma unroll
                for (int bj = 0; bj < 2; ++bj) *(u32x4*)(p + bj * HALF) = pack8(acc[ai][bj][m][0], acc[ai][bj][m][1]); }
    }
};
struct EpiPle { static constexpr bool PERM = true;
    float* X; bf16_t* XBo; const bf16_t* PU; float* y0; float* y1; const float* st; const float* cv; const float* gi; const float* bi; int last;
    __device__ __forceinline__ void operator()(AccRef acc, const Unit& u, int wr, int wc, int fr, int fq) const {
        const int row0 = u.pm * BM + wr * 64 + fr, col0 = u.pn * BM + wc * 32 + 8 * fq;
        float* yo = (u.pm < MP / BM) ? y0 : y1 - (size_t)MP * D;
        float rs[8], ts[8];
#pragma unroll
        for (int r = 0; r < 8; ++r) { float mu; ln_row(st, row0 + (r >> 2) * HALF + (r & 3) * 16, rs[r], ts[r], mu); }
#pragma unroll
        for (int bj = 0; bj < 2; ++bj) { const int c = col0 + bj * HALF;
            const f32x4 g0 = *(const f32x4*)(gi + c), g1 = *(const f32x4*)(gi + c + 4), b0 = *(const f32x4*)(bi + c), b1 = *(const f32x4*)(bi + c + 4);
            const f32x4 ca0 = *(const f32x4*)(cv + c), ca1 = *(const f32x4*)(cv + c + 4), cb0 = *(const f32x4*)(cv + D + c), cb1 = *(const f32x4*)(cv + D + c + 4);
#pragma unroll
            for (int ai = 0; ai < 2; ++ai)
#pragma unroll
                for (int m = 0; m < 4; ++m) { const int r = ai * 4 + m; const size_t o = (size_t)(row0 + ai * HALF + m * 16) * D + c; const float rstd = rs[r], t = ts[r];
                    const f32x4 x0 = (*(const f32x4*)(X + o) * rstd - t) * g0 + b0, x1 = (*(const f32x4*)(X + o + 4) * rstd - t) * g1 + b1;
                    const f32x4 a0 = fold4(acc[ai][bj][m][0], rstd, t, ca0, cb0), a1 = fold4(acc[ai][bj][m][1], rstd, t, ca1, cb1);
                    const u32x4 pw = *(const u32x4*)(PU + o);
                    const f32x4 p0 = {bflo(pw.x), bfhi(pw.x), bflo(pw.y), bfhi(pw.y)}, p1 = {bflo(pw.z), bfhi(pw.z), bflo(pw.w), bfhi(pw.w)};
                    f32x4 r0, r1;
#pragma unroll
                    for (int i = 0; i < 4; ++i) { r0[i] = x0[i] + sigmoidf_(a0[i]) * p0[i]; r1[i] = x1[i] + sigmoidf_(a1[i]) * p1[i]; }
                    if (last) { *(f32x4*)(yo + o) = r0; *(f32x4*)(yo + o + 4) = r1; }
                    else { *(f32x4*)(X + o) = r0; *(f32x4*)(X + o + 4) = r1; *(u32x4*)(XBo + o) = pack8(r0, r1); } } }
    }
};
}

#define XB_TMO      128
#define XB_XCNT(j)  (256  + 64 * (j))
#define XB_XSUB(j)  (1280 + 64 * (j))
#define XB_XGEN(j)  (2304 + 64 * (j))
#define XB_TOP      3328
#define XB_TOPGEN   3392
#define XCD_BAR_WORDS 3456
#define XB_SPIN_CAP (1u << 18)
__device__ __forceinline__ unsigned xb_ld(unsigned* p)              { return __hip_atomic_load(p, __ATOMIC_RELAXED, __HIP_MEMORY_SCOPE_AGENT); }
__device__ __forceinline__ unsigned xb_add(unsigned* p, unsigned v) { return __hip_atomic_fetch_add(p, v, __ATOMIC_RELAXED, __HIP_MEMORY_SCOPE_AGENT); }
__device__ __forceinline__ unsigned xb_xcc_id() { return (unsigned)__builtin_amdgcn_s_getreg((3 << 11) | 20) & 0xFu; }
#define XB_SPIN(cond, bar) do { unsigned _sp = 0; while (cond) { __builtin_amdgcn_s_sleep(1); \
    if ((++_sp & 255u) == 0u) { if (xb_ld(&(bar)[XB_TMO])) break; if (_sp > XB_SPIN_CAP) { atomicAdd(&(bar)[XB_TMO], 1u); break; } } } } while (0)
struct XcdBarrier { unsigned* bar; unsigned x; volatile LAS unsigned* st; };
__device__ __forceinline__ XcdBarrier xcd_barrier_post(unsigned* bar, volatile LAS unsigned* st) {
    XcdBarrier b; b.bar = bar; b.x = xb_xcc_id(); b.st = st;
    if (threadIdx.x == 0) (void)xb_add(&bar[XB_XCNT(b.x)], 1u);
    return b;
}
__device__ __forceinline__ void xcd_barrier_complete(unsigned* bar, unsigned x, unsigned& nloc, unsigned& nx) {
    const unsigned G = gridDim.x * gridDim.y * gridDim.z;
    unsigned sum, cnt, mine, sp = 0u;
    for (;;) {
        sum = 0u; cnt = 0u; mine = 0u;
#pragma unroll
        for (unsigned j = 0; j < 16; ++j) { const unsigned c = xb_ld(&bar[XB_XCNT(j)]); sum += c; cnt += (c > 0u) ? 1u : 0u; mine = (j == x) ? c : mine; }
        if (sum == G) break;
        __builtin_amdgcn_s_sleep(1);
        if ((++sp & 255u) == 0u) { if (xb_ld(&bar[XB_TMO])) break; if (sp > XB_SPIN_CAP) { atomicAdd(&bar[XB_TMO], 1u); break; } }
    }
    nloc = mine > 0u ? mine : 1u; nx = cnt > 0u ? cnt : 1u;
}
__device__ __forceinline__ void xcd_barrier(const XcdBarrier& b) {
    asm volatile("s_waitcnt vmcnt(0)" ::: "memory");
    __syncthreads();
    if (threadIdx.x == 0) {
        unsigned* bar = b.bar;
        __builtin_amdgcn_s_waitcnt(0);
        unsigned nloc = b.st[0], nx = b.st[1];
        if (nloc == 0u) { xcd_barrier_complete(bar, b.x, nloc, nx); b.st[0] = nloc; b.st[1] = nx; }
        const unsigned old = xb_add(&bar[XB_XSUB(b.x)], 1u);
        const unsigned gen = old / nloc;
        if (old + 1u == (gen + 1u) * nloc) {
            __builtin_amdgcn_fence(__ATOMIC_RELEASE, "agent");
            asm volatile("s_waitcnt vmcnt(0)" ::: "memory");
            const unsigned og = xb_add(&bar[XB_TOP], 1u);
            const unsigned tg = og / nx;
            if (og + 1u == (tg + 1u) * nx) xb_add(&bar[XB_TOPGEN], 1u);
            else XB_SPIN(xb_ld(&bar[XB_TOPGEN]) == tg, bar);
            __builtin_amdgcn_fence(__ATOMIC_ACQUIRE, "agent");
            xb_add(&bar[XB_XGEN(b.x)], 1u);
            asm volatile("s_waitcnt vmcnt(0)" ::: "memory");
        } else {
            XB_SPIN(xb_ld(&bar[XB_XGEN(b.x)]) == gen, bar);
            __builtin_amdgcn_fence(__ATOMIC_ACQUIRE, "agent");
            asm volatile("s_waitcnt vmcnt(0)" ::: "memory");
        }
    }
    __syncthreads();
}

struct Args { const float* in[29]; float* out; unsigned char* ws; int ph_lo, ph_hi; };
enum { I_XP = 0, I_XS, I_CK, I_CV, I_SPOOL, I_SHG, I_PP, I_PS, I_LNG, I_LNB, I_WG, I_WU, I_WD, I_WPG, I_WPU, I_WINE, I_WOUTE, I_POOLW, I_POOLS,
       I_LQ1, I_LK1, I_LQ2, I_LK2, I_DNG, I_RELB, I_WINO, I_WOUTO, I_HNG, I_LBL };
constexpr size_t O_YP = 0, O_YS = O_YP + (size_t)MP * D, O_KP = O_YS + (size_t)MS * D, O_VP = O_KP + (size_t)MP * DAW, O_KS = O_VP + (size_t)MP * DAW, O_VS = O_KS + (size_t)MS * DAW,
                 O_PLP = O_VS + (size_t)MS * DAW, O_PLS = O_PLP + (size_t)NB_P * 15 * POOLW, O_HGP = O_PLS + (size_t)NB_S * 15 * POOLW, O_HGS = O_HGP + (size_t)NB_P * HGH * 128 * 128,
                 O_END = O_HGS + (size_t)NB_S * HGH * 128 * 128;

__device__ __forceinline__ void tr_item(const float* W, int K, int N, bf16_t* WT, int k0, int n0, int drow0, LAS float* scr, int lane, const float* g, const float* b, float* cv, int ncv) {
#pragma unroll 8
    for (int i = 0; i < 32; ++i) { const int kk = 2 * i + (lane >> 5); scr[kk * 33 + (lane & 31)] = W[(size_t)(k0 + kk) * N + n0 + (lane & 31)]; }
    LDS_WAIT(); asm volatile("" ::: "memory");
    if (g) {
        const int n = lane & 31, kh = (lane >> 5) * 32; float s1 = 0.f, s2 = 0.f;
#pragma unroll 8
        for (int kk = 0; kk < 32; ++kk) { const float w = scr[(kh + kk) * 33 + n]; const float ws_ = w * g[k0 + kh + kk]; const float wr = bflo(cvt_pk_bf16(ws_, 0.f));
            scr[(kh + kk) * 33 + n] = wr; s1 += wr; s2 += w * b[k0 + kh + kk]; }
        s1 += __shfl_xor(s1, 32); s2 += __shfl_xor(s2, 32);
        if (lane < 32) { unsafeAtomicAdd(cv + drow0 + n, s1); unsafeAtomicAdd(cv + ncv + drow0 + n, s2); }
        LDS_WAIT(); asm volatile("" ::: "memory");
    }
    const int c = lane & 7;
#pragma unroll
    for (int j = 0; j < 4; ++j) { const int n = (lane >> 3) + 8 * j; const LAS float* sp = scr + (8 * c) * 33 + n;
        u32x4 o; o.x = cvt_pk_bf16(sp[0 * 33], sp[1 * 33]); o.y = cvt_pk_bf16(sp[2 * 33], sp[3 * 33]); o.z = cvt_pk_bf16(sp[4 * 33], sp[5 * 33]); o.w = cvt_pk_bf16(sp[6 * 33], sp[7 * 33]);
        *(u32x4*)(WT + (size_t)(drow0 + n) * K + k0 + 8 * c) = o; }
    LDS_WAIT(); asm volatile("" ::: "memory");
}
__device__ __forceinline__ void tr_matrix_item(const float* W, int K, int N, bf16_t* WT, int kind, int item, LAS float* scr, int lane, const float* g = nullptr, const float* b = nullptr, float* cv = nullptr, int ncv = 0) {
    const int nblk = N / 32, kb = item / nblk, nb = item % nblk, n0 = 32 * nb;
    const int drow0 = kind == 0 ? n0 : kind == 3 ? (512 * ((n0 & 2047) >> 7) + ((n0 >> 11) >> 1) * 256 + ((n0 >> 11) & 1) * 128 + (n0 & 127))
                                   : (256 * (n0 >> 7) + (n0 & 127) + (kind == 2 ? 128 : 0));
    tr_item(W, K, N, WT, 64 * kb, n0, drow0, scr, lane, g, b, cv, ncv);
}
__device__ __forceinline__ int t5_bucket(int rel) {
    const int n = rel < 0 ? -rel : rel; int b;
    if (n < 8) b = n; else { b = 8 + (n >= 12) + (n >= 16) + (n >= 23) + (n >= 32) + (n >= 46) + (n >= 64) + (n >= 91); }
    return b + (rel > 0 ? 16 : 0);
}
__device__ __forceinline__ void p0_prologue(const Args& a, LAS unsigned char* lds, int vcu, int NGW) {
    int tid = threadIdx.x; asm volatile("" : "+v"(tid)); const int lane = tid & 63, wave = __builtin_amdgcn_readfirstlane(tid >> 6);
    const int gw = vcu * 8 + wave;
    unsigned char* ws = a.ws;
    LAS float* scr = (LAS float*)(lds + wave * 16384);
    constexpr int I_GU = (D / 64) * (FF / 32), I_DN = (FF / 64) * (D / 32), I_INE = (D / 64) * (IN_EVEN / 32), I_SQ = (D / 64) * (D / 32), I_INO = (D / 64) * (IN_ODD / 32), I_PU = (PLE / 64) * (D / 32);
    constexpr int NITEMS = 4 * (2 * I_GU + I_DN) + I_INE + I_SQ + I_INO + I_SQ + 2 * I_SQ + 2 * I_PU;
    constexpr int I_FFN = 2 * I_GU + I_DN;
    for (int it = gw; it < NITEMS; it += NGW) {
        int r = it;
        if (r < 4 * I_FFN) { const int s = r / I_FFN; r -= s * I_FFN;
            bf16_t* wgu = (bf16_t*)(ws + WS_WGU) + (size_t)s * 2 * FF * D; bf16_t* wd = (bf16_t*)(ws + WS_WD) + (size_t)s * D * FF;
            const bool fold = (s & 1) != 0; const float* lg = fold ? a.in[I_LNG] + (size_t)((s >> 1) * 3 + 1) * D : nullptr; const float* lb_ = fold ? a.in[I_LNB] + (size_t)((s >> 1) * 3 + 1) * D : nullptr;
            float* cv = (float*)(ws + WS_C12) + ((s >> 1) ? C_UP1 : C_UP0);
            if (r < I_GU) tr_matrix_item(a.in[I_WG] + (size_t)s * D * FF, D, FF, wgu, 1, r, scr, lane, lg, lb_, cv, 2 * FF);
            else if (r < 2 * I_GU) tr_matrix_item(a.in[I_WU] + (size_t)s * D * FF, D, FF, wgu, 2, r - I_GU, scr, lane, lg, lb_, cv, 2 * FF);
            else tr_matrix_item(a.in[I_WD] + (size_t)s * FF * D, FF, D, wd, 0, r - 2 * I_GU, scr, lane);
            continue; }
        r -= 4 * I_FFN;
        if (r < I_INE) { tr_matrix_item(a.in[I_WINE], D, IN_EVEN, (bf16_t*)(ws + WS_WINE), 0, r, scr, lane, a.in[I_LNG], a.in[I_LNB], (float*)(ws + WS_C12) + C_INE, IN_EVEN); continue; } r -= I_INE;
        if (r < I_SQ) { tr_matrix_item(a.in[I_WOUTE], D, D, (bf16_t*)(ws + WS_WOUTE), 0, r, scr, lane); continue; } r -= I_SQ;
        if (r < I_INO) { tr_matrix_item(a.in[I_WINO], D, IN_ODD, (bf16_t*)(ws + WS_WINO), 3, r, scr, lane, a.in[I_LNG] + (size_t)3 * D, a.in[I_LNB] + (size_t)3 * D, (float*)(ws + WS_C12) + C_INO, IN_ODD); continue; } r -= I_INO;
        if (r < I_SQ) { tr_matrix_item(a.in[I_WOUTO], D, D, (bf16_t*)(ws + WS_WOUTO), 0, r, scr, lane); continue; } r -= I_SQ;
        if (r < I_SQ) { tr_matrix_item(a.in[I_WPG], D, D, (bf16_t*)(ws + WS_WPG), 0, r, scr, lane, a.in[I_LNG] + (size_t)2 * D, a.in[I_LNB] + (size_t)2 * D, (float*)(ws + WS_C12) + C_PG0, D); continue; } r -= I_SQ;
        if (r < I_SQ) { tr_matrix_item(a.in[I_WPG] + (size_t)D * D, D, D, (bf16_t*)(ws + WS_WPG) + (size_t)D * D, 0, r, scr, lane, a.in[I_LNG] + (size_t)5 * D, a.in[I_LNB] + (size_t)5 * D, (float*)(ws + WS_C12) + C_PG1, D); continue; } r -= I_SQ;
        if (r < I_PU) { tr_matrix_item(a.in[I_WPU], PLE, D, (bf16_t*)(ws + WS_WPU), 0, r, scr, lane); continue; } r -= I_PU;
        tr_matrix_item(a.in[I_WPU] + (size_t)PLE * D, PLE, D, (bf16_t*)(ws + WS_WPU) + (size_t)D * PLE, 0, r, scr, lane);
    }
    { const size_t gt = (size_t)gw * 64 + lane, GT = (size_t)NGW * 64; bf16_t* XB = (bf16_t*)(ws + WS_XB2);
      for (size_t i = gt; i < (size_t)M * D / 8; i += GT) { const size_t e = i * 8; const float* src = e < (size_t)MP * D ? a.in[I_XP] + e : a.in[I_XS] + (e - (size_t)MP * D);
          const f32x4 v0 = *(const f32x4*)src, v1 = *(const f32x4*)(src + 4); *(u32x4*)(XB + e) = pg8::pack8(v0, v1); }
      bf16_t* PB = (bf16_t*)(ws + WS_PB);
      for (size_t i = gt; i < (size_t)2 * M * PLE / 8; i += GT) { const size_t e = i * 8; const int l = (int)(e / ((size_t)M * PLE)); const size_t r = e - (size_t)l * M * PLE;
          const float* src = r < (size_t)MP * PLE ? a.in[I_PP] + (size_t)l * MP * PLE + r : a.in[I_PS] + (size_t)l * MS * PLE + (r - (size_t)MP * PLE);
          const f32x4 v0 = *(const f32x4*)src, v1 = *(const f32x4*)(src + 4); *(u32x4*)(PB + e) = pg8::pack8(v0, v1); }
      float* tb = (float*)(ws + WS_TAB + TAB_BIAS);
      for (size_t i = gt; i < (size_t)NH * 256; i += GT) { const int h = (int)(i >> 8), idx = (int)(i & 255); const int rel = idx - 191;
          const float* rb = a.in[I_RELB]; tb[i] = idx < 255 ? (rb[t5_bucket(rel) * NH + h] - rb[15 * NH + h]) * LOG2E : 0.f; }
      float* lbv = (float*)(ws + WS_TAB + TAB_LB);
      for (size_t i = gt; i < (size_t)D; i += GT) { const float l0 = a.in[I_LBL][i], l1 = a.in[I_LBL][D + i]; const float mx = fmaxf(l0, l1), e0 = __expf(l0 - mx), e1 = __expf(l1 - mx); lbv[i] = e1 / (e0 + e1); }
      bf16_t* pwt = (bf16_t*)(ws + WS_TAB + TAB_PWT);
      for (size_t i = gt; i < (size_t)4 * 128 * 128; i += GT) { const int g = (int)(i >> 14), n = (int)((i >> 7) & 127), k = (int)(i & 127);
          pwt[i] = (bf16_t)(cvt_pk_bf16(a.in[I_POOLW][((size_t)g * 128 + k) * 128 + n], 0.f) & 0xffffu); }
    }
}

__device__ __forceinline__ void ln_phase(const float* Z, float* X, bf16_t* XB, const float* g, const float* b, int vcu, int NGW) {
    int tid = threadIdx.x; asm volatile("" : "+v"(tid)); const int lane = tid & 63, wave = __builtin_amdgcn_readfirstlane(tid >> 6);
    const int gw = vcu * 8 + wave;
    f32x4 gv[8], bv[8];
#pragma unroll
    for (int j = 0; j < 8; ++j) { gv[j] = *(const f32x4*)(g + (j * 64 + lane) * 4); bv[j] = *(const f32x4*)(b + (j * 64 + lane) * 4); }
    for (int row = gw; row < M; row += NGW) {
        float* xr = X + (size_t)row * D; const float* zr = Z + (size_t)row * D; f32x4 v[8]; float s = 0.f;
#pragma unroll
        for (int j = 0; j < 8; ++j) { v[j] = *(const f32x4*)(zr + (j * 64 + lane) * 4); s += (v[j][0] + v[j][1]) + (v[j][2] + v[j][3]); }
        const float mean = wave_sum(s) * (1.f / D); float s2 = 0.f;
#pragma unroll
        for (int j = 0; j < 8; ++j) { v[j] = v[j] - mean; s2 += (v[j][0] * v[j][0] + v[j][1] * v[j][1]) + (v[j][2] * v[j][2] + v[j][3] * v[j][3]); }
        const float rstd = 1.f / sqrtf(wave_sum(s2) * (1.f / D) + LN_EPS);
        bf16_t* xb = XB + (size_t)row * D;
#pragma unroll
        for (int j = 0; j < 8; ++j) { const f32x4 o = v[j] * rstd * gv[j] + bv[j]; *(f32x4*)(xr + (j * 64 + lane) * 4) = o;
            u32x2 w; w.x = cvt_pk_bf16(o[0], o[1]); w.y = cvt_pk_bf16(o[2], o[3]); *(u32x2*)(xb + (j * 64 + lane) * 4) = w; }
    }
}

#define KSWZ(row, colB) ((row) * 256 + ((colB) ^ (((row) & 7) << 4)))
__device__ __forceinline__ int crow(int r, int hi) { return (r & 3) + 8 * (r >> 2) + 4 * hi; }
__device__ __forceinline__ void pool_phase(const Args& a, LAS unsigned char* lds) {
    int tid = threadIdx.x; asm volatile("" : "+v"(tid)); const int lane = tid & 63, wave = __builtin_amdgcn_readfirstlane(tid >> 6);
    const float* U = (const float*)(a.ws + WS_U); bf16_t* MIX = (bf16_t*)(a.ws + WS_MIX); const bf16_t* pwt = (const bf16_t*)(a.ws + WS_TAB + TAB_PWT);
    LAS float* full = (LAS float*)lds;
    LAS unsigned char* pa = lds + 40960;
    const int r32 = lane & 31, hi = lane >> 5;
    for (int unit = blockIdx.x; unit < (M / 64) * 4; unit += gridDim.x) {
        const int rb = unit >> 2, g = unit & 3, r0 = rb * 64; const bool smp = r0 >= MP;
        const int t0 = smp ? 0 : (r0 & (SEQ - 1)); const int bs = smp ? (r0 - MP) / DSEQ : 0;
        for (int p = tid; p < 79 * 32; p += 512) { const int i = p >> 5, c4 = (p & 31) * 4; const int t = t0 - 15 + i; f32x4 v = {0.f, 0.f, 0.f, 0.f};
            if (t >= 0) v = *(const f32x4*)(U + (size_t)(r0 - 15 + i) * POOLW + g * 128 + c4);
            else if (smp) v = *(const f32x4*)(a.in[I_SPOOL] + ((size_t)bs * 15 + (15 + t)) * POOLW + g * 128 + c4);
            *(LAS f32x4*)(full + i * 128 + c4) = v; }
        __syncthreads();
        { const int c = tid & 127, rq = tid >> 7, w = 2 << g;
          for (int tt = rq * 16; tt < rq * 16 + 16; ++tt) { float s = 0.f;
              for (int j = 0; j < w; ++j) s += full[(15 + tt - j) * 128 + c];
              const int cnt = smp ? w : ((t0 + tt + 1) < w ? (t0 + tt + 1) : w);
              const float pv = s / (float)cnt - full[(15 + tt) * 128 + c];
              *(LAS bf16_t*)(pa + KSWZ(tt, c * 2)) = (bf16_t)(cvt_pk_bf16(pv, 0.f) & 0xffffu); } }
        __syncthreads();
        { const int rt = wave >> 2, ct = wave & 3; f32x16 acc = {};
#pragma unroll
          for (int s = 0; s < 8; ++s) { const bf16x8 af = *(const LAS bf16x8*)(pa + KSWZ(32 * rt + r32, (16 * s + 8 * hi) * 2));
              const bf16x8 bfr = *(const bf16x8*)(pwt + ((size_t)g * 128 + 32 * ct + r32) * 128 + 16 * s + 8 * hi);
              acc = __builtin_amdgcn_mfma_f32_32x32x16_bf16(af, bfr, acc, 0, 0, 0); }
          const int n = g * 128 + 32 * ct + r32; const float sc = a.in[I_POOLS][n];
#pragma unroll
          for (int r = 0; r < 16; ++r) { const int row = r0 + 32 * rt + crow(r, hi); MIX[(size_t)row * D + n] = (bf16_t)(cvt_pk_bf16(acc[r] * sc, 0.f) & 0xffffu); } }
        __syncthreads();
    }
    { float* op = a.out + O_PLP; float* os = a.out + O_PLS;
      for (int i = blockIdx.x * 512 + tid; i < NB_P * 15 * POOLW; i += gridDim.x * 512) { const int c = i & 511, j = (i >> 9) % 15, b = i / (15 * POOLW); op[i] = U[((size_t)b * SEQ + SEQ - 15 + j) * POOLW + c]; }
      for (int i = blockIdx.x * 512 + tid; i < NB_S * 15 * POOLW; i += gridDim.x * 512) { const int c = i & 511, j = (i >> 9) % 15, b = i / (15 * POOLW); os[i] = U[((size_t)MP + (size_t)b * DSEQ + DSEQ - 15 + j) * POOLW + c]; } }
}

namespace att {
__device__ __forceinline__ int v_st(int k, int c) { const int kk = (k & ~0xC) | ((k & 4) << 1) | ((k & 8) >> 1); return ((kk >> 3) * 4 + (c >> 5)) * 512 + ((kk & 7) * 32 + (c & 31)) * 2; }
__device__ __forceinline__ int v_rd_base(int lane) { return ((lane & 3) << 3) | (((lane >> 2) & 3) << 6) | (((lane >> 4) & 1) << 5) | (((lane >> 5) & 1) << 8); }
constexpr int v_rd_off(int d0, int ks, int half) { return d0 * 512 + ks * 4096 + half * 2048; }
template <int OFF> __device__ __forceinline__ s16x4 tr_read(unsigned vb) { s16x4 r; asm volatile("ds_read_b64_tr_b16 %0, %1 offset:%2" : "=&v"(r) : "v"(vb), "i"(OFF) : "memory"); return r; }
template <int D0, int H> __device__ __forceinline__ void pv_half(f32x16& od, unsigned vb, bf16x8 pa0, bf16x8 pa1) {
    const s16x4 l0 = tr_read<v_rd_off(D0, 2 * H, 0)>(vb), h0 = tr_read<v_rd_off(D0, 2 * H, 1)>(vb), l1 = tr_read<v_rd_off(D0, 2 * H + 1, 0)>(vb), h1 = tr_read<v_rd_off(D0, 2 * H + 1, 1)>(vb);
    asm volatile("s_waitcnt lgkmcnt(0)" ::: "memory"); __builtin_amdgcn_sched_barrier(0);
#define PK(L, H_) (bf16x8){L[0], L[1], L[2], L[3], H_[0], H_[1], H_[2], H_[3]}
    od = __builtin_amdgcn_mfma_f32_32x32x16_bf16(pa0, PK(l0, h0), od, 0, 0, 0);
    od = __builtin_amdgcn_mfma_f32_32x32x16_bf16(pa1, PK(l1, h1), od, 0, 0, 0);
#undef PK
}
__device__ __forceinline__ u32x4 ld_bf8(const bf16_t* p) { return *(const u32x4*)p; }
__device__ __forceinline__ u32x4 ld_f8(const float* p) { const f32x4 a = *(const f32x4*)p, b = *(const f32x4*)(p + 4); return pg8::pack8(a, b); }

__device__ __forceinline__ void scores_h(f32x16& a, f32x16& b, const LAS unsigned char* Ks, int krow, const bf16x8* qr, int hi, bool near, const LAS float* tb, int idx) {
    a = (f32x16){}; b = (f32x16){};
#pragma unroll
    for (int d0 = 0; d0 < 4; ++d0) { const bf16x8 k0 = *(const LAS bf16x8*)(Ks + KSWZ(krow, (d0 * 16 + hi * 8) * 2)); a = __builtin_amdgcn_mfma_f32_32x32x16_bf16(k0, qr[d0], a, 0, 0, 0); }
#pragma unroll
    for (int d0 = 4; d0 < 8; ++d0) { const bf16x8 k0 = *(const LAS bf16x8*)(Ks + KSWZ(krow, (d0 * 16 + hi * 8) * 2)); b = __builtin_amdgcn_mfma_f32_32x32x16_bf16(k0, qr[d0], b, 0, 0, 0); }
    if (near) {
#pragma unroll
        for (int r = 0; r < 16; ++r) { const float v0 = tb[idx + (r & 3) + 8 * (r >> 2)]; a[r] += v0; b[r] += v0; }
    }
}
__device__ __forceinline__ float xhalf_max(float v) { auto rr = __builtin_amdgcn_permlane32_swap(__float_as_uint(v), __float_as_uint(v), false, false); return fmaxf(__uint_as_float(rr[0]), __uint_as_float(rr[1])); }
__device__ __forceinline__ float xhalf_sum(float v) { auto rr = __builtin_amdgcn_permlane32_swap(__float_as_uint(v), __float_as_uint(v), false, false); return __uint_as_float(rr[0]) + __uint_as_float(rr[1]); }
__device__ __forceinline__ void stat_update(float& m, float& l, const f32x16& x) {
    float mx = x[0];
#pragma unroll
    for (int r = 1; r < 16; ++r) mx = fmaxf(mx, x[r]);
    mx = xhalf_max(mx); const float mn = fmaxf(m, mx); float s = 0.f;
#pragma unroll
    for (int r = 0; r < 16; ++r) s += fast_exp2(x[r] - mn);
    l = l * fast_exp2(m - mn) + s; m = mn;
}
#define PK4(P, BASE, OUT) do { unsigned a0_ = cvt_pk_bf16(P[BASE + 0], P[BASE + 1]), a1_ = cvt_pk_bf16(P[BASE + 2], P[BASE + 3]);   \
    unsigned b0_ = cvt_pk_bf16(P[BASE + 4], P[BASE + 5]), b1_ = cvt_pk_bf16(P[BASE + 6], P[BASE + 7]);                              \
    auto r0_ = __builtin_amdgcn_permlane32_swap(a0_, b0_, false, false); auto r1_ = __builtin_amdgcn_permlane32_swap(a1_, b1_, false, false); \
    u32x4 w_ = {r0_[0], r1_[0], r0_[1], r1_[1]}; OUT = __builtin_bit_cast(bf16x8, w_); } while (0)

template <bool SAMPLE>
__device__ __forceinline__ void attn_unit(const Args& a, LAS unsigned char* lds, int uidx, int tid_in, int wave, float lam) {
    int tid = tid_in; asm volatile("" : "+v"(tid));
    const int lane = tid & 63, r32 = lane & 31, hi = lane >> 5;
    const bf16_t* QB = (const bf16_t*)(a.ws + WS_QB); const bf16_t* KB = (const bf16_t*)(a.ws + WS_KB); const bf16_t* VB = (const bf16_t*)(a.ws + WS_VB); bf16_t* MIX = (bf16_t*)(a.ws + WS_MIX);
    LAS float* tb = (LAS float*)(lds + LDS_ATAB);
    int b, h, qb = 0, h0 = 0;
    if (SAMPLE) { b = uidx / 3; h0 = (uidx % 3) * 4; h = h0 + (wave >> 1); }
    else { const int k = uidx; qb = 7 - k / (NB_P * NH); const int bh = k % (NB_P * NH); b = bh / NH; h = bh % NH; }
    const int nsteps = SAMPLE ? 33 : qb + 1;
    const int cw = SAMPLE ? 32 : 4 * qb + (wave >> 1);
    const size_t qrow = SAMPLE ? (size_t)MP + (size_t)b * DSEQ + 32 * (wave & 1) : (size_t)b * SEQ + qb * 256 + 32 * wave;
    if (SAMPLE) { for (int i = tid; i < 1024; i += 512) tb[i] = ((const float*)(a.ws + WS_TAB + TAB_BIAS))[(h0 + (i >> 8)) * 256 + (i & 255)]; }
    else { if (tid < 256) tb[tid] = ((const float*)(a.ws + WS_TAB + TAB_BIAS))[h * 256 + tid]; }
    const LAS float* tbw = tb + (SAMPLE ? 256 * (wave >> 1) : 0);
    bf16x8 qr[8];
    { const bf16_t* qp = QB + (qrow + r32) * DAW + h * HD + hi * 8;
#pragma unroll
      for (int d0 = 0; d0 < 8; ++d0) qr[d0] = *(const bf16x8*)(qp + d0 * 16); }
    const int sr = tid >> 4, sc = (tid & 15) * 8;
    const int kst0 = KSWZ(sr, sc * 2), kst1 = KSWZ(32 + sr, sc * 2), vst0 = v_st(sr, sc), vst1 = v_st(32 + sr, sc);
    float m1 = -1e30f, l1 = 0.f, m2 = -1e30f, l2 = 0.f;
    const int jlo = SAMPLE ? (wave >> 1) : 0, jhi = SAMPLE ? (wave >> 1) : 3;
    const int idxw = -64 * cw - 32 * (wave & 1) - r32 + 191 + 4 * hi;
#define ATT_STAGE(WITHV) do { _Pragma("unroll 1") for (int j = 0; j < 4; ++j) { LAS unsigned char* Ks = lds + j * 32768; LAS unsigned char* Vs = Ks + 16384;                    \
        if (SAMPLE) { const int hh = h0 + j; const float* kp; const float* vp; size_t rs;                                                                                  \
            if (s < 32) { const size_t o_ = (((size_t)b * PAST + 64 * s + sr) * NH + hh) * HD + sc; kp = a.in[I_CK] + o_; vp = a.in[I_CV] + o_; rs = (size_t)32 * NH * HD; }        \
            else { const size_t o_ = ((size_t)b * DSEQ + sr) * DAW + hh * HD + sc; kp = a.out + O_KS + o_; vp = a.out + O_VS + o_; rs = (size_t)32 * DAW; }                      \
            { const u32x4 k0 = ld_f8(kp), k1 = ld_f8(kp + rs); *(LAS u32x4*)(Ks + kst0) = k0; *(LAS u32x4*)(Ks + kst1) = k1; }                                             \
            if (WITHV) { const u32x4 v0 = ld_f8(vp), v1 = ld_f8(vp + rs); *(LAS u32x4*)(Vs + vst0) = v0; *(LAS u32x4*)(Vs + vst1) = v1; }                                    \
        } else { const size_t o_ = ((size_t)b * SEQ + 64 * (4 * s + j) + sr) * DAW + h * HD + sc;                                                                        \
            { const u32x4 k0 = ld_bf8(KB + o_), k1 = ld_bf8(KB + o_ + (size_t)32 * DAW); *(LAS u32x4*)(Ks + kst0) = k0; *(LAS u32x4*)(Ks + kst1) = k1; }                   \
            if (WITHV) { const u32x4 v0 = ld_bf8(VB + o_), v1 = ld_bf8(VB + o_ + (size_t)32 * DAW); *(LAS u32x4*)(Vs + vst0) = v0; *(LAS u32x4*)(Vs + vst1) = v1; } } } } while (0)
#pragma unroll 1
    for (int s = 0; s < nsteps; ++s) {
        ATT_STAGE(false);
        __syncthreads();
#pragma unroll 1
        for (int j = jlo; j <= jhi; ++j) { const int t = SAMPLE ? s : 4 * s + j;
            if (t > cw) break;
            const bool near = t >= cw - 2; const LAS unsigned char* Ks = lds + j * 32768; const int idx = near ? idxw + 64 * t : 0;
#pragma unroll
            for (int hf = 0; hf < 2; ++hf) { f32x16 x, y; scores_h(x, y, Ks, 32 * hf + r32, qr, hi, near, tbw, idx + 32 * hf); stat_update(m1, l1, x); stat_update(m2, l2, y); } }
        __syncthreads();
    }
    const float il1 = fast_rcp(xhalf_sum(l1)), cl2 = lam * fast_rcp(xhalf_sum(l2));
    f32x16 o[4] = {};
#pragma unroll 1
    for (int s = 0; s < nsteps; ++s) {
        ATT_STAGE(true);
        __syncthreads();
#pragma unroll 1
        for (int j = jlo; j <= jhi; ++j) { const int t = SAMPLE ? s : 4 * s + j;
            if (t > cw) break;
            const LAS unsigned char* Ks = lds + j * 32768; const bool near = t >= cw - 2; const int idx = near ? idxw + 64 * t : 0;
            const unsigned vb = (unsigned)(size_t)(Ks + 16384) + (unsigned)v_rd_base(lane);
            { f32x16 x, y; scores_h(x, y, Ks, r32, qr, hi, near, tbw, idx);
#pragma unroll
              for (int r = 0; r < 16; ++r) x[r] = fast_exp2(x[r] - m1) * il1 - fast_exp2(y[r] - m2) * cl2;
              bf16x8 pa0, pa1; PK4(x, 0, pa0); PK4(x, 8, pa1);
              pv_half<0, 0>(o[0], vb, pa0, pa1); pv_half<1, 0>(o[1], vb, pa0, pa1); pv_half<2, 0>(o[2], vb, pa0, pa1); pv_half<3, 0>(o[3], vb, pa0, pa1); }
            { f32x16 x, y; scores_h(x, y, Ks, 32 + r32, qr, hi, near, tbw, idx + 32);
#pragma unroll
              for (int r = 0; r < 16; ++r) x[r] = fast_exp2(x[r] - m1) * il1 - fast_exp2(y[r] - m2) * cl2;
              bf16x8 pa0, pa1; PK4(x, 0, pa0); PK4(x, 8, pa1);
              pv_half<0, 1>(o[0], vb, pa0, pa1); pv_half<1, 1>(o[1], vb, pa0, pa1); pv_half<2, 1>(o[2], vb, pa0, pa1); pv_half<3, 1>(o[3], vb, pa0, pa1); } }
        __syncthreads();
    }
#undef ATT_STAGE
    float ss[16];
#pragma unroll
    for (int r = 0; r < 16; ++r) { float v = o[0][r] * o[0][r] + o[1][r] * o[1][r] + o[2][r] * o[2][r] + o[3][r] * o[3][r];
#pragma unroll
        for (int sft = 1; sft < 32; sft <<= 1) v += __shfl_xor(v, sft);
        ss[r] = (1.f - LAM_INIT) / sqrtf(v * (1.f / HD) + LN_EPS); }
    float gq[4];
#pragma unroll
    for (int d0 = 0; d0 < 4; ++d0) gq[d0] = a.in[I_DNG][32 * d0 + r32];
#pragma unroll
    for (int r = 0; r < 16; ++r) { bf16_t* op = MIX + (qrow + crow(r, hi)) * D + POOLW + h * HD + r32;
#pragma unroll
        for (int d0 = 0; d0 < 4; ++d0) op[32 * d0] = (bf16_t)(cvt_pk_bf16(o[d0][r] * ss[r] * gq[d0], 0.f) & 0xffffu); }
}
constexpr int N_SAMPLE_UNITS = NB_S * 3, N_PROMPT_UNITS = NB_P * NH * 8, N_UNITS = N_SAMPLE_UNITS + N_PROMPT_UNITS;
}

__device__ __forceinline__ void attn_phase(const Args& a, LAS unsigned char* lds, int rep) {
    int tid = threadIdx.x; asm volatile("" : "+v"(tid)); const int lane = tid & 63, wave = __builtin_amdgcn_readfirstlane(tid >> 6);
    float lam;
    { const float p1 = a.in[I_LQ1][lane] * a.in[I_LK1][lane], p2 = a.in[I_LQ2][lane] * a.in[I_LK2][lane]; lam = __expf(wave_sum(p1)) - __expf(wave_sum(p2)) + LAM_INIT; }
    unsigned* qhead = (unsigned*)(a.ws + WS_CTL) + CW_QATT + 64 * rep;
    volatile LAS unsigned* bc = (volatile LAS unsigned*)(lds + LDS_MISC + 64);
    for (;;) {
        if (tid == 0) *bc = atomicAdd(qhead, 1u);
        __syncthreads();
        const int u = (int)*bc;
        __syncthreads();
        if (u >= att::N_UNITS) break;
        if (u < att::N_SAMPLE_UNITS) att::attn_unit<true>(a, lds, u, tid, wave, lam);
        else att::attn_unit<false>(a, lds, u - att::N_SAMPLE_UNITS, tid, wave, lam);
    }
}

namespace hg {
constexpr int SLOT = 21504, NSLOT = 5, OT = NSLOT * SLOT;
__device__ __forceinline__ s16x4 trr(unsigned addr) { s16x4 r; asm volatile("ds_read_b64_tr_b16 %0, %1" : "=&v"(r) : "v"(addr) : "memory"); return r; }
#define DPP_ROR(v, n) __builtin_bit_cast(float, __builtin_amdgcn_update_dpp(0, __builtin_bit_cast(int, v), 0x120 + (n), 0xf, 0xf, false))
__device__ __forceinline__ float sum16(float x) { x += DPP_ROR(x, 8); x += DPP_ROR(x, 4); x += DPP_ROR(x, 2); x += DPP_ROR(x, 1); return x; }
#undef DPP_ROR
}
__device__ __forceinline__ void hgrn_phase(const Args& a, LAS unsigned char* lds) {
    int tid = threadIdx.x; asm volatile("" : "+v"(tid)); const int lane = tid & 63, w = __builtin_amdgcn_readfirstlane(tid >> 6);
    const int g = lane >> 4, el = lane & 15;
    unsigned srcoff[5]; int dstoff[5];
#pragma unroll
    for (int i = 0; i < 5; ++i) { const int piece = 5 * (w & 3) + i, arr = piece >> 2, rg = piece & 3, row = 4 * rg + g;
        const unsigned abase = arr == 0 ? 0u : arr == 1 ? (unsigned)(WS_KI - WS_QE) : arr == 2 ? (unsigned)(WS_KD - WS_QE) : arr == 3 ? (unsigned)(WS_VV - WS_QE) : (unsigned)(WS_GG - WS_QE);
        srcoff[i] = abase + (unsigned)row * (D * 2) + (unsigned)((el ^ row) << 4); dstoff[i] = arr * 4096 + rg * 1024; }
    const unsigned aq0 = (unsigned)(el * 256 + 8 * (g & 1)), aqx = (unsigned)(g >> 1);
    const int tk = 4 * g + (el >> 2), pp = el & 3;
    const unsigned atr = (unsigned)(tk * 256 + 8 * (pp & 1));
    const int ftok = 4 * (w & 3) + g;
    const f32x4 gn0 = *(const f32x4*)(a.in[I_HNG] + 8 * el), gn1 = *(const f32x4*)(a.in[I_HNG] + 8 * el + 4);
    for (int unit = blockIdx.x; unit < NB_P * HGH + NB_S * HGH; unit += gridDim.x) {
        const bool smp = unit >= NB_P * HGH; const int bh = smp ? unit - NB_P * HGH : unit; const int b = bh >> 4, h = bh & 15;
        const int NC = smp ? DSEQ / 16 : SEQ / 16; const size_t row0 = smp ? (size_t)MP + (size_t)b * DSEQ : (size_t)b * SEQ;
        f32x4 S[8];
        if (smp) { const float* sp = a.in[I_SHG] + (((size_t)b * HGH + h) * 128 + 4 * g) * 128 + 16 * w + el;
#pragma unroll
            for (int mt = 0; mt < 8; ++mt)
#pragma unroll
                for (int r = 0; r < 4; ++r) S[mt][r] = sp[(size_t)(16 * mt + r) * 128]; }
        else {
#pragma unroll
            for (int mt = 0; mt < 8; ++mt) S[mt] = (f32x4){0.f, 0.f, 0.f, 0.f}; }
        const unsigned char* ubase = a.ws + WS_QE + row0 * (D * 2) + (size_t)h * 256;
        const float* ebase = (const float*)(a.ws + WS_EB) + (row0 >> 4) * D + h * 128 + (lane & 31) * 4;
        bf16_t* obase = (bf16_t*)(a.ws + WS_MIX) + (row0 + ftok) * D + h * 128 + 8 * el;
        asm volatile("s_waitcnt vmcnt(0)" ::: "memory");
#pragma unroll
        for (int mt = 0; mt < 8; ++mt) asm volatile("" : "+v"(S[mt]));
#define HG_DMA(c, slotp) do { if (w < 4) { const int cc_ = (c) < NC ? (c) : NC - 1; const unsigned char* ub_ = ubase + (size_t)cc_ * (16 * D * 2);                     \
        _Pragma("unroll") for (int i_ = 0; i_ < 5; ++i_) __builtin_amdgcn_global_load_lds((const unsigned*)(ub_ + srcoff[i_]), (LAS unsigned*)((slotp) + dstoff[i_]), 16, 0, 0);     \
        if (w == 0) __builtin_amdgcn_global_load_lds((const unsigned*)(ebase + (size_t)cc_ * D), (LAS unsigned*)((slotp) + 20480), 16, 0, 0); } } while (0)
        HG_DMA(0, lds); HG_DMA(1, lds + hg::SLOT); HG_DMA(2, lds + 2 * hg::SLOT);
        int si = 0;
#pragma unroll 1
        for (int c = 0; c <= NC; ++c) {
            if (w == 0) asm volatile("s_waitcnt vmcnt(12)" ::: "memory"); else if (w < 4) asm volatile("s_waitcnt vmcnt(10)" ::: "memory");
            asm volatile("s_waitcnt lgkmcnt(0)" ::: "memory"); __builtin_amdgcn_s_barrier(); asm volatile("" ::: "memory");
            { const int s3 = si + 3 >= hg::NSLOT ? si + 3 - hg::NSLOT : si + 3; HG_DMA(c + 3, lds + s3 * hg::SLOT); }
            const LAS unsigned char* sl = lds + si * hg::SLOT; const unsigned slb = (unsigned)(size_t)sl;
            if (c < NC) {
                f32x4 oacc = {0.f, 0.f, 0.f, 0.f};
                bf16x8 qf[4];
#pragma unroll
                for (int ks = 0; ks < 4; ++ks) { const unsigned c0 = (unsigned)(4 * ks) + aqx;
                    const u32x2 lo = *(const LAS u32x2*)(sl + aq0 + (((c0) ^ (unsigned)el) << 4)), hi2 = *(const LAS u32x2*)(sl + aq0 + (((c0 + 2) ^ (unsigned)el) << 4));
                    u32x4 qv = {lo.x, lo.y, hi2.x, hi2.y}; qf[ks] = __builtin_bit_cast(bf16x8, qv);
                    u32x4 sv = {cvt_pk_bf16(S[2 * ks][0], S[2 * ks][1]), cvt_pk_bf16(S[2 * ks][2], S[2 * ks][3]), cvt_pk_bf16(S[2 * ks + 1][0], S[2 * ks + 1][1]), cvt_pk_bf16(S[2 * ks + 1][2], S[2 * ks + 1][3])};
                    oacc = __builtin_amdgcn_mfma_f32_16x16x32_bf16(qf[ks], __builtin_bit_cast(bf16x8, sv), oacc, 0, 0, 0); }
                f32x4 at = {0.f, 0.f, 0.f, 0.f};
#pragma unroll
                for (int ks = 0; ks < 4; ++ks) { const unsigned c0 = (unsigned)(4 * ks) + aqx;
                    const u32x2 lo = *(const LAS u32x2*)(sl + 4096 + aq0 + (((c0) ^ (unsigned)el) << 4)), hi2 = *(const LAS u32x2*)(sl + 4096 + aq0 + (((c0 + 2) ^ (unsigned)el) << 4));
                    u32x4 kv = {lo.x, lo.y, hi2.x, hi2.y};
                    at = __builtin_amdgcn_mfma_f32_16x16x32_bf16(__builtin_bit_cast(bf16x8, kv), qf[ks], at, 0, 0, 0); }
#pragma unroll
                for (int r = 0; r < 4; ++r) at[r] = (4 * g + r <= el) ? at[r] : 0.f;
                const s16x4 vt = hg::trr(slb + 12288 + atr + ((((unsigned)(2 * w) + (unsigned)(pp >> 1)) ^ (unsigned)tk) << 4));
                s16x4 kt[8];
#pragma unroll
                for (int mt = 0; mt < 8; ++mt) kt[mt] = hg::trr(slb + 8192 + atr + ((((unsigned)(2 * mt) + (unsigned)(pp >> 1)) ^ (unsigned)tk) << 4));
                asm volatile("s_waitcnt lgkmcnt(0)" ::: "memory"); __builtin_amdgcn_sched_barrier(0);
                const bf16x8 vfr = {vt[0], vt[1], vt[2], vt[3], 0, 0, 0, 0};
                { u32x4 av = {cvt_pk_bf16(at[0], at[1]), cvt_pk_bf16(at[2], at[3]), 0u, 0u};
                  oacc = __builtin_amdgcn_mfma_f32_16x16x32_bf16(__builtin_bit_cast(bf16x8, av), vfr, oacc, 0, 0, 0); }
#pragma unroll
                for (int mt = 0; mt < 8; ++mt) { const f32x4 e4 = *(const LAS f32x4*)(sl + 20480 + (16 * mt + 4 * g) * 4);
                    const bf16x8 kfr = {kt[mt][0], kt[mt][1], kt[mt][2], kt[mt][3], 0, 0, 0, 0};
                    S[mt] = __builtin_amdgcn_mfma_f32_16x16x32_bf16(kfr, vfr, S[mt] * e4, 0, 0, 0); }
                LAS float* ot = (LAS float*)(lds + hg::OT + (c & 1) * 8192) + (4 * g) * 128 + 16 * w + el;
#pragma unroll
                for (int r = 0; r < 4; ++r) ot[r * 128] = oacc[r];
            }
            if (w >= 4 && c > 0) {
                const int sp = si == 0 ? hg::NSLOT - 1 : si - 1;
                const LAS float* ot = (const LAS float*)(lds + hg::OT + ((c - 1) & 1) * 8192) + ftok * 128 + 8 * el;
                const f32x4 o0 = *(const LAS f32x4*)ot, o1 = *(const LAS f32x4*)(ot + 4);
                const u32x4 gw = *(const LAS u32x4*)(lds + sp * hg::SLOT + 16384 + ftok * 256 + ((el ^ ftok) << 4));
                float ssq = (o0[0] * o0[0] + o0[1] * o0[1]) + (o0[2] * o0[2] + o0[3] * o0[3]) + (o1[0] * o1[0] + o1[1] * o1[1]) + (o1[2] * o1[2] + o1[3] * o1[3]);
                ssq = hg::sum16(ssq); const float rstd = 1.f / sqrtf(ssq * (1.f / 128) + LN_EPS);
                const f32x4 g0 = {bflo(gw.x), bfhi(gw.x), bflo(gw.y), bfhi(gw.y)}, g1 = {bflo(gw.z), bfhi(gw.z), bflo(gw.w), bfhi(gw.w)};
                *(u32x4*)(obase + (size_t)(16 * (c - 1)) * D) = pg8::pack8(o0 * rstd * gn0 * g0, o1 * rstd * gn1 * g1);
            }
            si = si + 1 >= hg::NSLOT ? 0 : si + 1;
        }
#undef HG_DMA
        asm volatile("s_waitcnt vmcnt(0)" ::: "memory");
        { float* sp = a.out + (smp ? O_HGS : O_HGP) + (((size_t)b * HGH + h) * 128 + 4 * g) * 128 + 16 * w + el;
#pragma unroll
          for (int mt = 0; mt < 8; ++mt)
#pragma unroll
              for (int r = 0; r < 4; ++r) sp[(size_t)(16 * mt + r) * 128] = S[mt][r]; }
        asm volatile("s_waitcnt vmcnt(0) lgkmcnt(0)" ::: "memory"); __builtin_amdgcn_s_barrier(); asm volatile("" ::: "memory");
    }
}

constexpr int N_PHASES = 19;
__global__ void __launch_bounds__(512, 2) fwd(Args a) {
    extern __shared__ __attribute__((aligned(16))) unsigned char lds_raw[];
    LAS unsigned char* lds = (LAS unsigned char*)lds_raw;
    const int tid = threadIdx.x;
    const int G = gridDim.x; const int vcu = (G % 8 == 0) ? ((int)blockIdx.x % 8) * (G / 8) + (int)blockIdx.x / 8 : (int)blockIdx.x;
    const int NGW = G * 8;
    for (int u = tid; u < 64; u += 512) ((LAS unsigned*)(lds + LDS_MISC))[u] = 0u;
    __syncthreads();
#if MK_ONE_LAUNCH
    XcdBarrier bar = xcd_barrier_post((unsigned*)(a.ws + WS_CTL) + CW_BAR, (volatile LAS unsigned*)(lds + LDS_MISC + 32));
#define GRID_BAR() xcd_barrier(bar)
#else
#define GRID_BAR() do {} while (0)
#endif
    const int lo = a.ph_lo, hi = a.ph_hi;
#ifndef PHASE_MASK
#define PHASE_MASK 0xFFFF
#endif
#define KIND(n) (((PHASE_MASK) >> (n)) & 1)
#define IN(k) (lo <= (k) && (k) < hi)
#define SEAM(k) do { if (IN(k) && IN((k) + 1)) GRID_BAR(); } while (0)
#define WSP(T, off) ((T*)(wsp_() + (off)))
    auto wsp_ = [&]() -> unsigned char* { unsigned char* p_ = a.ws; asm volatile("" : "+s"(p_)); return p_; };
#define X WSP(float, WS_X)
#define XB WSP(bf16_t, WS_XB)
#define XB2 WSP(bf16_t, WS_XB2)
#define H WSP(bf16_t, WS_H)
#define MIX WSP(bf16_t, WS_MIX)
#define PU WSP(bf16_t, WS_PU)
#define STAT(i) (WSP(float, WS_STATS) + (size_t)(i) * M * 2)
#define CV(off) (WSP(float, WS_C12) + (off))

    if (KIND(0) && IN(0)) { for (int rep = 0; rep < REP_P0; ++rep) p0_prologue(a, lds, vcu, NGW); } SEAM(0);

#pragma unroll 1
    for (int l = 0; l < 2; ++l) {
        const int pb = 1 + 9 * l;
        const float* lng = a.in[I_LNG] + (size_t)l * 3 * D; const float* lnb = a.in[I_LNB] + (size_t)l * 3 * D;
#pragma unroll 1
        for (int j = 0; j < 2; ++j) {
            const int p = pb + 5 * j; const int s = 2 * l + j;
            if (KIND(1) && IN(p)) { pg8::Gemm g{j == 0 ? XB2 : XB, (const bf16_t*)(wsp_() + WS_WGU) + (size_t)s * 2 * FF * D, M, 2 * FF, D}; pg8::StaticOrder S; S.init(M, 2 * FF, G, (int)blockIdx.x);
                pg8::EpiFfnUp E{H, j == 0 ? nullptr : STAT(3 * l + 1), CV(l == 0 ? C_UP0 : C_UP1)};
                for (int rep = 0; rep < REP_UP; ++rep) pg8::gemm_phase<pg8::EpiFfnUp, pg8::StaticOrder, true, true>(lds, g, S, E); }
            SEAM(p);
            if (KIND(2) && IN(p + 1)) { pg8::Gemm g{H, (const bf16_t*)(wsp_() + WS_WD) + (size_t)s * D * FF, M, D, FF}; pg8::StaticOrder S; S.init(M, D, G, (int)blockIdx.x);
                const bool first = (l == 0 && j == 0);
                pg8::EpiResid E{first ? a.in[I_XP] : X, first ? a.in[I_XS] : X + (size_t)MP * D, X, XB, j == 0 ? nullptr : STAT(3 * l + 1), lng + D, lnb + D, STAT(3 * l + 2 * j), ALPHA, 0.5f};
                pg8::gemm_phase<pg8::EpiResid, pg8::StaticOrder, true, true>(lds, g, S, E); }
            SEAM(p + 1);
            if (j == 0) {
                if (l == 0) {
                    if (KIND(4) && IN(pb + 2)) { pg8::Gemm g{XB, (const bf16_t*)(wsp_() + WS_WINE), M, IN_EVEN, D}; pg8::StaticOrder S; S.init(M, IN_EVEN, G, (int)blockIdx.x);
                        pg8::EpiInEven E{(float*)(wsp_() + WS_U), (bf16_t*)(wsp_() + WS_QB), (bf16_t*)(wsp_() + WS_KB), (bf16_t*)(wsp_() + WS_VB), a.out + O_KP, a.out + O_KS, a.out + O_VP, a.out + O_VS, STAT(0), CV(C_INE)};
                        for (int rep = 0; rep < REP_INE; ++rep) pg8::gemm_phase<pg8::EpiInEven, pg8::StaticOrder, true, true>(lds, g, S, E); }
                    SEAM(pb + 2);
                    if (IN(pb + 3)) { if (KIND(5)) for (int rep = 0; rep < REP_ATT; ++rep) attn_phase(a, lds, rep); if (KIND(6)) for (int rep = 0; rep < REP_POOL; ++rep) pool_phase(a, lds); }
                    SEAM(pb + 3);
                } else {
                    if (KIND(7) && IN(pb + 2)) { pg8::Gemm g{XB, (const bf16_t*)(wsp_() + WS_WINO), M, IN_ODD, D}; pg8::StaticOrder S; S.init(M, IN_ODD, G, (int)blockIdx.x);
                        pg8::EpiInOdd E{wsp_(), (const float*)(wsp_() + WS_TAB + TAB_LB), STAT(3), CV(C_INO)};
                        pg8::gemm_phase<pg8::EpiInOdd, pg8::StaticOrder, true, true>(lds, g, S, E); }
                    SEAM(pb + 2);
                    if (KIND(8) && IN(pb + 3)) for (int rep = 0; rep < REP_HG; ++rep) hgrn_phase(a, lds);
                    SEAM(pb + 3);
                }
                if (KIND(9) && IN(pb + 4)) { pg8::Gemm g{MIX, (const bf16_t*)(wsp_() + (l == 0 ? WS_WOUTE : WS_WOUTO)), M, D, D}; pg8::StaticOrder S; S.init(M, D, G, (int)blockIdx.x);
                    pg8::EpiResid E{X, X + (size_t)MP * D, X, XB, STAT(3 * l), lng, lnb, STAT(3 * l + 1), ALPHA, 1.0f};
                    pg8::gemm_phase<pg8::EpiResid, pg8::StaticOrder, true, true>(lds, g, S, E); }
                SEAM(pb + 4);
            }
        }
        if (KIND(10) && IN(pb + 7)) { pg8::Gemm g{(const bf16_t*)(wsp_() + WS_PB) + (size_t)l * M * PLE, (const bf16_t*)(wsp_() + WS_WPU) + (size_t)l * D * PLE, M, D, PLE}; pg8::StaticOrder S; S.init(M, D, G, (int)blockIdx.x);
            pg8::EpiBf16 E{PU, D}; pg8::gemm_phase<pg8::EpiBf16, pg8::StaticOrder, true, true>(lds, g, S, E); }
        SEAM(pb + 7);
        if (KIND(11) && IN(pb + 8)) { pg8::Gemm g{XB, (const bf16_t*)(wsp_() + WS_WPG) + (size_t)l * D * D, M, D, D}; pg8::StaticOrder S; S.init(M, D, G, (int)blockIdx.x);
            pg8::EpiPle E{X, XB2, PU, a.out + O_YP, a.out + O_YS, STAT(3 * l + 2), CV(l == 0 ? C_PG0 : C_PG1), lng + 2 * D, lnb + 2 * D, l == 1 ? 1 : 0};
            pg8::gemm_phase<pg8::EpiPle, pg8::StaticOrder, true, true>(lds, g, S, E); }
        SEAM(pb + 8);
    }
#undef IN
#undef SEAM
#undef X
#undef XB
#undef XB2
#undef H
#undef MIX
#undef PU
#undef STAT
#undef CV
#undef WSP
}

extern "C" void kernel_launch(void* const* d_in, const int* in_sizes, int n_in, void* d_out, int out_size, void* d_ws, size_t ws_size, hipStream_t stream) {
    static int grid = 0;
    if (grid == 0) {
        if (n_in != 29 || (size_t)out_size != O_END || ws_size < WS_END) { fprintf(stderr, "kernel_launch: shape mismatch: n_in %d out %d (want %zu) ws %zu (want >= %zu)\n", n_in, out_size, (size_t)O_END, ws_size, (size_t)WS_END); grid = -1; return; }
        int dev = 0, cus = 0, per_cu = 0;
        if (hipGetDevice(&dev) != hipSuccess || hipDeviceGetAttribute(&cus, hipDeviceAttributeMultiprocessorCount, dev) != hipSuccess) { fprintf(stderr, "kernel_launch: device query failed\n"); grid = -1; return; }
        if (hipFuncSetAttribute((const void*)fwd, hipFuncAttributeMaxDynamicSharedMemorySize, LDS_BYTES) != hipSuccess) { fprintf(stderr, "kernel_launch: hipFuncSetAttribute failed\n"); grid = -1; return; }
        if (hipOccupancyMaxActiveBlocksPerMultiprocessor(&per_cu, (const void*)fwd, 512, LDS_BYTES) != hipSuccess || per_cu < 1) fprintf(stderr, "kernel_launch: occupancy query reports %d blocks per CU\n", per_cu);
        (void)hipGetLastError();
        grid = cus;
    }
    if (grid < 0) return;
    if (hipMemsetAsync((char*)d_ws + WS_CTL, 0, CTL_ZERO_BYTES, stream) != hipSuccess) { fprintf(stderr, "kernel_launch: memset failed\n"); return; }
    Args a{};
    for (int i = 0; i < 29; ++i) a.in[i] = (const float*)d_in[i];
    a.out = (float*)d_out; a.ws = (unsigned char*)d_ws;
#if MK_ONE_LAUNCH
    a.ph_lo = 0; a.ph_hi = N_PHASES;
    hipLaunchKernelGGL(fwd, dim3(grid), dim3(512), LDS_BYTES, stream, a);
#else
    for (int p = 0; p < N_PHASES; ++p) { a.ph_lo = p; a.ph_hi = p + 1; hipLaunchKernelGGL(fwd, dim3(grid), dim3(512), LDS_BYTES, stream, a); }
#endif
    const hipError_t le = hipPeekAtLastError();
    if (le != hipSuccess) fprintf(stderr, "kernel_launch: launch failed: %s\n", hipGetErrorName(le));
}
```

```cpp
#include <hip/hip_runtime.h>
#include <cstdio>
#include <cstdint>

#ifndef MK_ONE_LAUNCH
#define MK_ONE_LAUNCH 1
#endif

#ifndef REP_P0
#define REP_P0 1
#endif
#ifndef REP_UP
#define REP_UP 1
#endif
#ifndef REP_ATT
#define REP_ATT 1
#endif
#ifndef REP_POOL
#define REP_POOL 1
#endif
#ifndef REP_HG
#define REP_HG 1
#endif
#ifndef REP_LN
#define REP_LN 1
#endif
#ifndef REP_DN
#define REP_DN 1
#endif
#ifndef REP_INE
#define REP_INE 1
#endif
#define LAS __attribute__((address_space(3)))
#define GAS __attribute__((address_space(1)))
typedef unsigned short bf16_t;
typedef short bf16x8 __attribute__((ext_vector_type(8)));
typedef short s16x4 __attribute__((ext_vector_type(4)));
typedef float f32x2 __attribute__((ext_vector_type(2)));
typedef float f32x4 __attribute__((ext_vector_type(4)));
typedef float f32x16 __attribute__((ext_vector_type(16)));
typedef unsigned u32x2 __attribute__((ext_vector_type(2)));
typedef unsigned u32x4 __attribute__((ext_vector_type(4)));

constexpr int D = 2048, FF = 5632, MP = 32768, MS = 2048, M = MP + MS, SEQ = 2048, DSEQ = 64, NB_P = 16, NB_S = 32, PAST = 2048;
constexpr int PLE = 256, POOLW = 512, DAW = 1536, NH = 12, HD = 128, IN_EVEN = 5120, IN_ODD = 8192, HGH = 16;
constexpr float ALPHA = 1.4142135623730951f, LN_EPS = 1e-5f, LOG2E = 1.4426950408889634f;
constexpr float QSCALE = 0.125f * LOG2E;
constexpr float LAM_INIT = 0.2f;

constexpr size_t MiB = 1u << 20;
constexpr size_t WS_CTL = 0, CTL_ZERO_BYTES = 4 * MiB;
constexpr size_t WS_STATS = 1 * MiB;
constexpr size_t WS_C12 = 3 * MiB;
constexpr int C_INE = 0, C_INO = C_INE + 2 * 5120, C_UP0 = C_INO + 2 * 8192, C_UP1 = C_UP0 + 2 * 11264, C_PG0 = C_UP1 + 2 * 11264, C_PG1 = C_PG0 + 2 * 2048, C_END = C_PG1 + 2 * 2048;
static_assert(WS_STATS + (size_t)6 * 34816 * 2 * 4 <= WS_C12 && WS_C12 + (size_t)C_END * 4 <= CTL_ZERO_BYTES, "CTL map");
constexpr size_t WS_TAB = 4 * MiB;
constexpr size_t TAB_BIAS = 0;
constexpr size_t TAB_LB = 16384;
constexpr size_t TAB_PWT = 65536;
constexpr size_t WS_WGU = 5 * MiB;
constexpr size_t WS_WD = WS_WGU + 176 * MiB;
constexpr size_t WS_WINE = WS_WD + 88 * MiB;
constexpr size_t WS_WOUTE = WS_WINE + 20 * MiB;
constexpr size_t WS_WINO = WS_WOUTE + 8 * MiB;
constexpr size_t WS_WOUTO = WS_WINO + 32 * MiB;
constexpr size_t WS_WPG = WS_WOUTO + 8 * MiB;
constexpr size_t WS_WPU = WS_WPG + 16 * MiB;
constexpr size_t WS_X = WS_WPU + 2 * MiB;
constexpr size_t WS_XB = WS_X + 272 * MiB;
constexpr size_t WS_PB = WS_XB + 136 * MiB;
constexpr size_t WS_R = WS_PB + 34 * MiB;
constexpr size_t WS_H = WS_R;
constexpr size_t WS_PU = WS_R;
constexpr size_t WS_U = WS_R;
constexpr size_t WS_QB = WS_U + 68 * MiB;
constexpr size_t WS_KB = WS_QB + 102 * MiB;
constexpr size_t WS_VB = WS_KB + 96 * MiB;
constexpr size_t WS_MIX = WS_R + 816 * MiB;
constexpr size_t WS_QE = WS_R;
constexpr size_t WS_KI = WS_QE + 136 * MiB;
constexpr size_t WS_VV = WS_KI + 136 * MiB;
constexpr size_t WS_GG = WS_VV + 136 * MiB;
constexpr size_t WS_KD = WS_GG + 136 * MiB;
constexpr size_t WS_EB = WS_KD + 136 * MiB;
static_assert(WS_EB + 17 * MiB <= WS_MIX && WS_VB + 96 * MiB <= WS_MIX && WS_H + 374 * MiB <= WS_MIX, "overlay map");
constexpr size_t WS_XB2 = WS_R + 374 * MiB;
constexpr size_t WS_END = WS_MIX + 136 * MiB;

constexpr int CW_BAR = 4096;
constexpr int CW_QATT = 64;

constexpr int LDS_BYTES = 147456;
constexpr int LDS_ATAB = 131072;
constexpr int LDS_MISC = 139264;

__device__ __forceinline__ unsigned cvt_pk_bf16(float lo, float hi) { unsigned r; asm volatile("v_cvt_pk_bf16_f32 %0, %1, %2" : "=v"(r) : "v"(lo), "v"(hi)); return r; }
__device__ __forceinline__ float bf2f(unsigned short b) { return __builtin_bit_cast(float, (unsigned)b << 16); }
__device__ __forceinline__ float bflo(unsigned w) { return __builtin_bit_cast(float, w << 16); }
__device__ __forceinline__ float bfhi(unsigned w) { return __builtin_bit_cast(float, w & 0xffff0000u); }
__device__ __forceinline__ float fast_exp2(float x) { return __builtin_amdgcn_exp2f(x); }
__device__ __forceinline__ float fast_rcp(float x) { return __builtin_amdgcn_rcpf(x); }
__device__ __forceinline__ float sigmoidf_(float x) { return fast_rcp(1.f + fast_exp2(-x * LOG2E)); }
__device__ __forceinline__ float wave_sum(float v) {
#pragma unroll
    for (int o = 1; o < 64; o <<= 1) v += __shfl_xor(v, o);
    return v;
}
#define LDS_WAIT() asm volatile("s_waitcnt lgkmcnt(0)" ::: "memory")
#define VM_WAIT() asm volatile("s_waitcnt vmcnt(0)" ::: "memory")

namespace pg8 {
constexpr int BM = 256, BK = 64, HALF = 128, HTB = HALF * BK * 2, STAGE_BYTES = 8 * HTB, NXCD = 8, WGM = 8;
__host__ __device__ __forceinline__ int lds_byte(int r, int c) { const int st = (r >> 4) * 2 + (c >> 5), rr = r & 15, cc = c & 31, ob = rr * 64 + cc * 2; return st * 1024 + (ob ^ (((ob >> 9) & 1) << 5)); }
__host__ __device__ __forceinline__ void stage_rc(int b, int& R, int& C) { const int st = b / 1024, sb = b % 1024, swz = sb ^ (((sb >> 9) & 1) << 5); R = (st >> 1) * 16 + swz / 64; C = (st & 1) * 32 + (swz % 64) / 2; }
__host__ __device__ __forceinline__ int perm32(int rho) { const int n = rho >> 4, i = rho & 15; return 8 * (i >> 2) + 4 * n + (i & 3); }
struct Unit { int pm, pn; };
struct Gemm { const bf16_t* A; const bf16_t* Bt; int M, N, K; };
struct StaticOrder {
    int nM, nN, nwg, G, c;
    __host__ __device__ void init(int M_, int N_, int G_, int c_) { nM = M_ / BM; nN = N_ / BM; nwg = nM * nN; G = G_; c = c_; }
    __host__ __device__ bool next(int i, Unit& u) const {
        const long L = (long)i * G + c; if (L >= nwg) return false;
        int wgid = (int)L; { const int q = nwg / NXCD, r = nwg % NXCD, xcd = wgid % NXCD, off = wgid / NXCD; wgid = (xcd < r ? xcd * (q + 1) : r * (q + 1) + (xcd - r) * q) + off; }
        const int nig = WGM * nN, gid = wgid / nig, fm = gid * WGM, gsz = (nM - fm) < WGM ? (nM - fm) : WGM;
        u.pm = fm + ((wgid % nig) % gsz); u.pn = (wgid % nig) / gsz; return true;
    }
    __device__ __forceinline__ void a_ready(const Unit&) const {}
    __device__ __forceinline__ void done(const Unit&) const {}
};

template <class Epi, class Sched, bool ALIGN_EPI = false, bool SP2 = false>
__device__ __forceinline__ void gemm_phase(LAS unsigned char* lds, const Gemm g, const Sched& S, const Epi& E) {
    int tid = threadIdx.x; asm volatile("" : "+v"(tid));
    const int wid = __builtin_amdgcn_readfirstlane(tid >> 6), lane = tid & 63, wr = wid >> 2, wc = wid & 3, fr = lane & 15, fq = lane >> 4;
    int K = g.K; asm volatile("" : "+s"(K));
    const int nt = K / BK;
    unsigned voffA[2], voffB[2];
#pragma unroll
    for (int i = 0; i < 2; ++i) { int R, C; stage_rc(tid * 16 + i * 8192, R, C); const int Rb = Epi::PERM ? ((R & ~31) + perm32(R & 31)) : R;
        voffA[i] = (unsigned)(R * K + C) * 2u; voffB[i] = (unsigned)(Rb * K + C) * 2u; }
    const size_t kstep = (size_t)(BK * 2);
    const size_t hstep = (size_t)HALF * K * 2;
    const size_t tstep = 2 * hstep;
    const unsigned ldsw = (unsigned)wid * 1024u;
    const int aoff = lds_byte(wr * 64 + fr, fq * 8), boff = lds_byte(wc * 32 + fr, fq * 8);
#define PG8_SA(b, h) (((b) * 2 + (h)) * HTB)
#define PG8_SB(b, h) ((4 + (b) * 2 + (h)) * HTB)
#define PG8_STAGE(bufoff, gbase, voff) do { _Pragma("unroll") for (int _i = 0; _i < 2; ++_i) \
        __builtin_amdgcn_global_load_lds((const unsigned*)((const char*)(gbase) + (voff)[_i]), (LAS unsigned*)(lds + (bufoff) + ldsw + _i * 8192), 16, 0, 0); } while (0)
#define PG8_LDA(dst, b, h) do { _Pragma("unroll") for (int m = 0; m < 4; ++m) _Pragma("unroll") for (int k = 0; k < 2; ++k) dst[m][k] = *(const LAS bf16x8*)(lds + PG8_SA(b, h) + aoff + m * 2048 + k * 1024); } while (0)
#define PG8_LDB(dst, b, h) do { _Pragma("unroll") for (int n = 0; n < 2; ++n) _Pragma("unroll") for (int k = 0; k < 2; ++k) dst[n][k] = *(const LAS bf16x8*)(lds + PG8_SB(b, h) + boff + n * 2048 + k * 1024); } while (0)
#define PG8_MMA(ai, bj, At, Bt) do { __builtin_amdgcn_s_setprio(1); _Pragma("unroll") for (int m = 0; m < 4; ++m) _Pragma("unroll") for (int n = 0; n < 2; ++n) _Pragma("unroll") for (int k = 0; k < 2; ++k) \
        acc[ai][bj][m][n] = __builtin_amdgcn_mfma_f32_16x16x32_bf16(Bt[n][k], At[m][k], acc[ai][bj][m][n], 0, 0, 0); __builtin_amdgcn_s_setprio(0); } while (0)
#define PG8_WAIT_V(n) asm volatile("s_waitcnt vmcnt(" #n ")" ::: "memory")
#define PG8_WAIT_L(n) asm volatile("s_waitcnt lgkmcnt(" #n ")" ::: "memory")
#define PG8_BAR __builtin_amdgcn_s_barrier()
#define PG8_SCHED __builtin_amdgcn_sched_barrier(0)
    Unit cur, nxt; int ui = 0;
    if (!S.next(0, cur)) return;
    f32x4 acc[2][2][4][2];
#pragma unroll
    for (int a = 0; a < 2; ++a)
#pragma unroll
        for (int b = 0; b < 2; ++b)
#pragma unroll
            for (int m = 0; m < 4; ++m)
#pragma unroll
                for (int n = 0; n < 2; ++n) acc[a][b][m][n] = (f32x4){0.f, 0.f, 0.f, 0.f};
    bf16x8 At[4][2], B0[2][2], B1[2][2];
    const char* cA = (const char*)g.A + (size_t)cur.pm * tstep; const char* cB = (const char*)g.Bt + (size_t)cur.pn * tstep;
    S.a_ready(cur);
    if constexpr (SP2) {
        PG8_STAGE(PG8_SB(0, 0), cB, voffB); PG8_STAGE(PG8_SB(0, 1), cB + hstep, voffB); PG8_STAGE(PG8_SA(0, 0), cA, voffA); PG8_STAGE(PG8_SA(0, 1), cA + hstep, voffA);
        if (wr == 1) PG8_BAR;
        PG8_WAIT_V(2); PG8_BAR;
        PG8_STAGE(PG8_SB(1, 0), cB + kstep, voffB); PG8_STAGE(PG8_SA(1, 0), cA + kstep, voffA); PG8_STAGE(PG8_SB(1, 1), cB + hstep + kstep, voffB);
        PG8_WAIT_V(6); PG8_BAR;
    } else {
        PG8_STAGE(PG8_SB(0, 0), cB, voffB); PG8_STAGE(PG8_SA(0, 0), cA, voffA); PG8_STAGE(PG8_SB(0, 1), cB + hstep, voffB); PG8_STAGE(PG8_SA(0, 1), cA + hstep, voffA);
        if (wr == 1) PG8_BAR;
        PG8_WAIT_V(4); PG8_BAR;
        PG8_STAGE(PG8_SB(1, 0), cB + kstep, voffB); PG8_STAGE(PG8_SA(1, 0), cA + kstep, voffA); PG8_STAGE(PG8_SB(1, 1), cB + hstep + kstep, voffB);
        PG8_WAIT_V(6); PG8_BAR;
    }
    for (;;) {
        const bool has_next = S.next(ui + 1, nxt);
        const char* nA = has_next ? (const char*)g.A + (size_t)nxt.pm * tstep : cA; const char* nB = has_next ? (const char*)g.Bt + (size_t)nxt.pn * tstep : cB;
        for (int t = 0; t < nt; t += 2) {
            const bool last = (t == nt - 2);
            const char* a1 = cA + (size_t)(t + 1) * kstep;
            const char* a2 = last ? nA : cA + (size_t)(t + 2) * kstep; const char* b2 = last ? nB : cB + (size_t)(t + 2) * kstep;
            const char* a3 = a2 + kstep; const char* b3 = b2 + kstep;
            if (last && has_next) S.a_ready(nxt);
            if constexpr (SP2) {
            PG8_LDB(B0, 0, 0); PG8_LDB(B1, 0, 1); PG8_SCHED; PG8_LDA(At, 0, 0); PG8_STAGE(PG8_SA(1, 1), a1 + hstep, voffA);
            PG8_WAIT_V(8); PG8_WAIT_L(0); PG8_BAR; PG8_MMA(0, 0, At, B0); PG8_MMA(0, 1, At, B1); PG8_BAR; PG8_SCHED;
            PG8_LDA(At, 0, 1); PG8_STAGE(PG8_SB(0, 0), b2, voffB); PG8_STAGE(PG8_SB(0, 1), b2 + hstep, voffB); PG8_STAGE(PG8_SA(0, 0), a2, voffA);
            PG8_WAIT_V(8); PG8_WAIT_L(0); PG8_BAR; PG8_MMA(1, 0, At, B0); PG8_MMA(1, 1, At, B1); PG8_BAR; PG8_SCHED;
            PG8_LDB(B0, 1, 0); PG8_LDB(B1, 1, 1); PG8_SCHED; PG8_LDA(At, 1, 0); PG8_STAGE(PG8_SA(0, 1), a2 + hstep, voffA);
            PG8_WAIT_V(8); PG8_WAIT_L(0); PG8_BAR; PG8_MMA(0, 0, At, B0); PG8_MMA(0, 1, At, B1); PG8_BAR; PG8_SCHED;
            PG8_LDA(At, 1, 1); PG8_STAGE(PG8_SB(1, 0), b3, voffB); PG8_STAGE(PG8_SB(1, 1), b3 + hstep, voffB); PG8_STAGE(PG8_SA(1, 0), a3, voffA);
            PG8_WAIT_V(8); PG8_WAIT_L(0); PG8_BAR; PG8_MMA(1, 0, At, B0); PG8_MMA(1, 1, At, B1); PG8_BAR; PG8_SCHED;
            } else {
            PG8_LDB(B0, 0, 0); PG8_SCHED; PG8_LDA(At, 0, 0); PG8_STAGE(PG8_SA(1, 1), a1 + hstep, voffA);
            PG8_WAIT_L(8); PG8_BAR; PG8_WAIT_L(0); PG8_MMA(0, 0, At, B0); PG8_BAR; PG8_SCHED;
            PG8_LDB(B1, 0, 1); PG8_STAGE(PG8_SB(0, 0), b2, voffB);
            PG8_BAR; PG8_WAIT_L(0); PG8_MMA(0, 1, At, B1); PG8_BAR;
            PG8_LDA(At, 0, 1); PG8_STAGE(PG8_SA(0, 0), a2, voffA);
            PG8_BAR; PG8_WAIT_L(0); PG8_MMA(1, 0, At, B0); PG8_BAR; PG8_SCHED;
            PG8_STAGE(PG8_SB(0, 1), b2 + hstep, voffB);
            PG8_WAIT_V(6); PG8_BAR; PG8_MMA(1, 1, At, B1); PG8_BAR;
            PG8_LDB(B0, 1, 0); PG8_SCHED; PG8_LDA(At, 1, 0); PG8_STAGE(PG8_SA(0, 1), a2 + hstep, voffA);
            PG8_WAIT_L(8); PG8_BAR; PG8_WAIT_L(0); PG8_MMA(0, 0, At, B0); PG8_BAR; PG8_SCHED;
            PG8_LDB(B1, 1, 1); PG8_STAGE(PG8_SB(1, 0), b3, voffB);
            PG8_BAR; PG8_WAIT_L(0); PG8_MMA(0, 1, At, B1); PG8_BAR;
            PG8_LDA(At, 1, 1); PG8_STAGE(PG8_SA(1, 0), a3, voffA);
            PG8_BAR; PG8_WAIT_L(0); PG8_MMA(1, 0, At, B0); PG8_BAR; PG8_SCHED;
            PG8_STAGE(PG8_SB(1, 1), b3 + hstep, voffB);
            PG8_WAIT_V(6); PG8_BAR; PG8_MMA(1, 1, At, B1); PG8_BAR;
            }
        }
        if constexpr (ALIGN_EPI) { if (wr == 0) PG8_BAR; }
        E(acc, cur, wr, wc, fr, fq); S.done(cur);
        if (!has_next) break;
#pragma unroll
        for (int a = 0; a < 2; ++a)
#pragma unroll
            for (int b = 0; b < 2; ++b)
#pragma unroll
                for (int m = 0; m < 4; ++m)
#pragma unroll
                    for (int n = 0; n < 2; ++n) acc[a][b][m][n] = (f32x4){0.f, 0.f, 0.f, 0.f};
        cur = nxt; cA = nA; cB = nB; ++ui;
        if constexpr (ALIGN_EPI) { if (wr == 1) PG8_BAR; }
    }
    PG8_WAIT_V(0);
    if constexpr (!ALIGN_EPI) { if (wr == 0) PG8_BAR; }
    PG8_BAR;
#undef PG8_SA
#undef PG8_SB
#undef PG8_STAGE
#undef PG8_LDA
#undef PG8_LDB
#undef PG8_MMA
#undef PG8_WAIT_V
#undef PG8_WAIT_L
#undef PG8_BAR
#undef PG8_SCHED
}

typedef const f32x4 (&AccRef)[2][2][4][2];
__device__ __forceinline__ u32x4 pack8(f32x4 a, f32x4 b) { u32x4 w; w.x = cvt_pk_bf16(a[0], a[1]); w.y = cvt_pk_bf16(a[2], a[3]); w.z = cvt_pk_bf16(b[0], b[1]); w.w = cvt_pk_bf16(b[2], b[3]); return w; }
__device__ __forceinline__ f32x4 silu4(f32x4 g) { f32x4 r;
#pragma unroll
    for (int i = 0; i < 4; ++i) r[i] = g[i] * fast_rcp(1.f + fast_exp2(-g[i] * LOG2E));
    return r; }

__device__ __forceinline__ void ln_row(const float* st, int row, float& rstd, float& t  , float& mu) {
    const f32x2 sv = *(const f32x2*)(st + 2 * (size_t)row); mu = sv.x * (1.f / D); const float var = sv.y * (1.f / D) - mu * mu; rstd = __builtin_amdgcn_rsqf(var + LN_EPS); t = mu * rstd; }
__device__ __forceinline__ f32x4 fold4(f32x4 acc, float rstd, float t, f32x4 c1, f32x4 c2) { return acc * rstd + (c2 - c1 * t); }

struct EpiFfnUp { static constexpr bool PERM = true;
    bf16_t* H; const float* st; const float* cv;
    __device__ __forceinline__ void operator()(AccRef acc, const Unit& u, int wr, int wc, int fr, int fq) const {
        const int row0 = u.pm * BM + wr * 64 + fr, col0 = u.pn * HALF + wc * 32 + 8 * fq, ct = u.pn * BM + wc * 32 + 8 * fq;
        f32x4 c1g[2], c1u[2], c2g[2], c2u[2];
        if (st) {
#pragma unroll
            for (int n = 0; n < 2; ++n) { c1g[n] = *(const f32x4*)(cv + ct + 4 * n); c1u[n] = *(const f32x4*)(cv + ct + HALF + 4 * n); c2g[n] = *(const f32x4*)(cv + 2 * FF + ct + 4 * n); c2u[n] = *(const f32x4*)(cv + 2 * FF + ct + HALF + 4 * n); } }
#pragma unroll
        for (int ai = 0; ai < 2; ++ai)
#pragma unroll
            for (int m = 0; m < 4; ++m) { const int row = row0 + ai * HALF + m * 16; bf16_t* p = H + (size_t)row * FF + col0;
                f32x4 g0 = acc[ai][0][m][0], g1 = acc[ai][0][m][1], u0 = acc[ai][1][m][0], u1 = acc[ai][1][m][1];
                if (st) { float rstd, t, mu; ln_row(st, row, rstd, t, mu); g0 = fold4(g0, rstd, t, c1g[0], c2g[0]); g1 = fold4(g1, rstd, t, c1g[1], c2g[1]); u0 = fold4(u0, rstd, t, c1u[0], c2u[0]); u1 = fold4(u1, rstd, t, c1u[1], c2u[1]); }
                *(u32x4*)p = pack8(silu4(g0) * u0, silu4(g1) * u1); }
    }
};
struct EpiResid { static constexpr bool PERM = true;
    const float* xf0; const float* xf1; const bf16_t* xb; bf16_t* ZB; const float* si; const float* gi; const float* bi; float* so; float alpha, beta;
    __device__ __forceinline__ void operator()(AccRef acc, const Unit& u, int wr, int wc, int fr, int fq) const {
        const int row0 = u.pm * BM + wr * 64 + fr, col0 = u.pn * BM + wc * 32 + 8 * fq;
        const float* xs = (u.pm < MP / BM) ? xf0 : xf1 - (size_t)MP * D;
        f32x4 gv[2][2], bv[2][2];
#pragma unroll
        for (int bj = 0; bj < 2; ++bj)
#pragma unroll
            for (int n = 0; n < 2; ++n) { gv[bj][n] = (f32x4){1.f, 1.f, 1.f, 1.f}; bv[bj][n] = (f32x4){0.f, 0.f, 0.f, 0.f};
                if (si) { gv[bj][n] = *(const f32x4*)(gi + col0 + bj * HALF + 4 * n); bv[bj][n] = *(const f32x4*)(bi + col0 + bj * HALF + 4 * n); } }
#pragma unroll
        for (int ai = 0; ai < 2; ++ai)
#pragma unroll
            for (int m = 0; m < 4; ++m) { const int row = row0 + ai * HALF + m * 16; const size_t off = (size_t)row * D + col0;
                float rstd = 1.f, t = 0.f, mu = 0.f; if (si) ln_row(si, row, rstd, t, mu);
                float s1 = 0.f, s2 = 0.f;
#pragma unroll
                for (int bj = 0; bj < 2; ++bj) { f32x4 x0, x1;
                    if (xb) { const u32x4 w = *(const u32x4*)(xb + off + bj * HALF); x0 = (f32x4){bflo(w.x), bfhi(w.x), bflo(w.y), bfhi(w.y)}; x1 = (f32x4){bflo(w.z), bfhi(w.z), bflo(w.w), bfhi(w.w)}; }
                    else { x0 = *(const f32x4*)(xs + off + bj * HALF); x1 = *(const f32x4*)(xs + off + bj * HALF + 4); }
                    if (si) { x0 = (x0 * rstd - t) * gv[bj][0] + bv[bj][0]; x1 = (x1 * rstd - t) * gv[bj][1] + bv[bj][1]; }
                    const f32x4 z0 = x0 * alpha + acc[ai][bj][m][0] * beta, z1 = x1 * alpha + acc[ai][bj][m][1] * beta;
                    *(u32x4*)(ZB + off + bj * HALF) = pack8(z0, z1);
                    s1 += (z0[0] + z0[1]) + (z0[2] + z0[3]) + (z1[0] + z1[1]) + (z1[2] + z1[3]);
                    s2 += (z0[0] * z0[0] + z0[1] * z0[1]) + (z0[2] * z0[2] + z0[3] * z0[3]) + (z1[0] * z1[0] + z1[1] * z1[1]) + (z1[2] * z1[2] + z1[3] * z1[3]); }
                s1 += __shfl_xor(s1, 16); s2 += __shfl_xor(s2, 16); s1 += __shfl_xor(s1, 32); s2 += __shfl_xor(s2, 32);
                if (fq == 0) { unsafeAtomicAdd(so + 2 * (size_t)row, s1); unsafeAtomicAdd(so + 2 * (size_t)row + 1, s2); }
                if (m & 1) __builtin_amdgcn_sched_barrier(0); }
    }
};
struct EpiInEven { static constexpr bool PERM = true;
    float* U; bf16_t* QB; bf16_t* KB; bf16_t* VB; float* nk0; float* nk1; float* nv0; float* nv1; const float* st; const float* cv;
    __device__ __forceinline__ void operator()(AccRef acc, const Unit& u, int wr, int wc, int fr, int fq) const {
        const int row0 = u.pm * BM + wr * 64 + fr, cin = wc * 32 + 8 * fq, ct = u.pn * BM + cin; const bool prompt = u.pm < MP / BM;
        f32x4 c1[2][2], c2[2][2];
#pragma unroll
        for (int bj = 0; bj < 2; ++bj)
#pragma unroll
            for (int n = 0; n < 2; ++n) { c1[bj][n] = *(const f32x4*)(cv + ct + bj * HALF + 4 * n); c2[bj][n] = *(const f32x4*)(cv + IN_EVEN + ct + bj * HALF + 4 * n); }
        const int kind = u.pn < 2 ? 0 : u.pn < 8 ? 1 : u.pn < 14 ? 2 : 3; const int col0 = (u.pn - (kind == 0 ? 0 : kind == 1 ? 2 : kind == 2 ? 8 : 14)) * BM + cin;
        float* o32 = kind == 2 ? (prompt ? nk0 : nk1 - (size_t)MP * DAW) : (prompt ? nv0 : nv1 - (size_t)MP * DAW); bf16_t* o16 = kind == 2 ? KB : VB;
#pragma unroll
        for (int ai = 0; ai < 2; ++ai)
#pragma unroll
            for (int m = 0; m < 4; ++m) { const int row = row0 + ai * HALF + m * 16; float rstd, t, mu; ln_row(st, row, rstd, t, mu);
#pragma unroll
                for (int bj = 0; bj < 2; ++bj) { const f32x4 v0 = fold4(acc[ai][bj][m][0], rstd, t, c1[bj][0], c2[bj][0]), v1 = fold4(acc[ai][bj][m][1], rstd, t, c1[bj][1], c2[bj][1]);
                    if (kind == 0) { float* p = U + (size_t)row * POOLW + col0 + bj * HALF; *(f32x4*)p = v0; *(f32x4*)(p + 4) = v1; }
                    else if (kind == 1) { *(u32x4*)(QB + (size_t)row * DAW + col0 + bj * HALF) = pack8(v0 * QSCALE, v1 * QSCALE); }
                    else { const size_t off = (size_t)row * DAW + col0 + bj * HALF; *(f32x4*)(o32 + off) = v0; *(f32x4*)(o32 + off + 4) = v1; if (prompt) *(u32x4*)(o16 + off) = pack8(v0, v1); } } }
    }
};
__device__ __forceinline__ float scan16(float x) {
#define DPP_SHR(v, n) __builtin_bit_cast(float, __builtin_amdgcn_update_dpp(0, __builtin_bit_cast(int, v), 0x110 + (n), 0xf, 0xf, true))
    x += DPP_SHR(x, 1); x += DPP_SHR(x, 2); x += DPP_SHR(x, 4); x += DPP_SHR(x, 8);
#undef DPP_SHR
    return x; }
struct EpiInOdd { static constexpr bool PERM = true;
    unsigned char* wsb; const float* lbv; const float* st; const float* cv;
    __device__ __forceinline__ void operator()(AccRef acc, const Unit& u, int wr, int wc, int fr, int fq) const {
        const int row0 = u.pm * BM + wr * 64 + fr, cb = (u.pn >> 1) * HALF + wc * 32 + 8 * fq, ct = u.pn * BM + wc * 32 + 8 * fq;
#define AT(T, base, boff) ((T*)(wsb + (size_t)(unsigned)((base) + (boff))))
        f32x4 c1[2][2], c2[2][2];
#pragma unroll
        for (int bj = 0; bj < 2; ++bj)
#pragma unroll
            for (int n = 0; n < 2; ++n) { c1[bj][n] = *(const f32x4*)(cv + ct + bj * HALF + 4 * n); c2[bj][n] = *(const f32x4*)(cv + IN_ODD + ct + bj * HALF + 4 * n); }
        if ((u.pn & 1) == 0) {
            const f32x4 lb0 = *(const f32x4*)(lbv + cb), lb1 = *(const f32x4*)(lbv + cb + 4);
            const int l15 = (int)((threadIdx.x & 48u) | 15u);
#pragma unroll
            for (int ai = 0; ai < 2; ++ai)
#pragma unroll
                for (int m = 0; m < 4; ++m) { const int row = row0 + ai * HALF + m * 16; const unsigned off = ((unsigned)row * D + cb) * 2u;
                    float rstd, t, mu; ln_row(st, row, rstd, t, mu);
                    f32x4 qe[2], ki[2], kd[2]; float* e = AT(float, (unsigned)WS_EB, ((unsigned)(row >> 4) * D + cb) * 4u);
#pragma unroll
                    for (int n = 0; n < 2; ++n) { const f32x4 qv = fold4(acc[ai][0][m][n], rstd, t, c1[0][n], c2[0][n]), zv = fold4(acc[ai][1][m][n], rstd, t, c1[1][n], c2[1][n]);
#pragma unroll
                        for (int i = 0; i < 4; ++i) { const float q = qv[i], z = zv[i], lb = n ? lb1[i] : lb0[i];
                            const float sg = fast_rcp(1.f + fast_exp2(-z * LOG2E)); const float f = lb + (1.f - lb) * sg, kk = (1.f - lb) * (1.f - sg);
                            const float b = scan16(__builtin_amdgcn_logf(f)); const float bl = __shfl(b, l15, 64);
                            qe[n][i] = q * fast_rcp(1.f + fast_exp2(-q * LOG2E)) * fast_exp2(b); ki[n][i] = kk * fast_exp2(-b); kd[n][i] = kk * fast_exp2(bl - b);
                            if (fr == 15) e[4 * n + i] = fast_exp2(b); } }
                    *AT(u32x4, (unsigned)WS_QE, off) = pack8(qe[0], qe[1]); *AT(u32x4, (unsigned)WS_KI, off) = pack8(ki[0], ki[1]); *AT(u32x4, (unsigned)WS_KD, off) = pack8(kd[0], kd[1]);
                    __builtin_amdgcn_sched_barrier(0); }
        } else {
#pragma unroll
            for (int ai = 0; ai < 2; ++ai)
#pragma unroll
                for (int m = 0; m < 4; ++m) { const int row = row0 + ai * HALF + m * 16; const unsigned off = ((unsigned)row * D + cb) * 2u; float rstd, t, mu; ln_row(st, row, rstd, t, mu);
                    *AT(u32x4, (unsigned)WS_VV, off) = pack8(fold4(acc[ai][0][m][0], rstd, t, c1[0][0], c2[0][0]), fold4(acc[ai][0][m][1], rstd, t, c1[0][1], c2[0][1]));
                    *AT(u32x4, (unsigned)WS_GG, off) = pack8(silu4(fold4(acc[ai][1][m][0], rstd, t, c1[1][0], c2[1][0])), silu4(fold4(acc[ai][1][m][1], rstd, t, c1[1][1], c2[1][1]))); }
        }
#undef AT
    }
};
struct EpiBf16 { static constexpr bool PERM = true;
    bf16_t* O; int ldc;
    __device__ __forceinline__ void operator()(AccRef acc, const Unit& u, int wr, int wc, int fr, int fq) const {
        const int row0 = u.pm * BM + wr * 64 + fr, col0 = u.pn * BM + wc * 32 + 8 * fq;
#pragma unroll
        for (int ai = 0; ai < 2; ++ai)
#pragma unroll
            for (int m = 0; m < 4; ++m) { bf16_t* p = O + (size_t)(row0 + ai * HALF + m * 16) * ldc + col0;
#pragma unroll
                for (int bj = 0; bj < 2; ++bj) *(u32x4*)(p + bj * HALF) = pack8(acc[ai][bj][m][0], acc[ai][bj][m][1]); }
    }
};
struct EpiPle { static constexpr bool PERM = true;
    const bf16_t* ZB; bf16_t* XBo; const bf16_t* PU; float* y0; float* y1; const float* st; const float* cv; const float* gi; const float* bi; int last;
    __device__ __forceinline__ void operator()(AccRef acc, const Unit& u, int wr, int wc, int fr, int fq) const {
        const int row0 = u.pm * BM + wr * 64 + fr, col0 = u.pn * BM + wc * 32 + 8 * fq;
        float* yo = (u.pm < MP / BM) ? y0 : y1 - (size_t)MP * D;
        float rs[8], ts[8];
#pragma unroll
        for (int r = 0; r < 8; ++r) { float mu; ln_row(st, row0 + (r >> 2) * HALF + (r & 3) * 16, rs[r], ts[r], mu); }
#pragma unroll
        for (int bj = 0; bj < 2; ++bj) { const int c = col0 + bj * HALF;
            const f32x4 g0 = *(const f32x4*)(gi + c), g1 = *(const f32x4*)(gi + c + 4), b0 = *(const f32x4*)(bi + c), b1 = *(const f32x4*)(bi + c + 4);
            const f32x4 ca0 = *(const f32x4*)(cv + c), ca1 = *(const f32x4*)(cv + c + 4), cb0 = *(const f32x4*)(cv + D + c), cb1 = *(const f32x4*)(cv + D + c + 4);
#pragma unroll
            for (int ai = 0; ai < 2; ++ai)
#pragma unroll
                for (int m = 0; m < 4; ++m) { const int r = ai * 4 + m; const size_t o = (size_t)(row0 + ai * HALF + m * 16) * D + c; const float rstd = rs[r], t = ts[r];
                    const u32x4 zw = *(const u32x4*)(ZB + o), pw = *(const u32x4*)(PU + o);
                    const f32x4 zf0 = {bflo(zw.x), bfhi(zw.x), bflo(zw.y), bfhi(zw.y)}, zf1 = {bflo(zw.z), bfhi(zw.z), bflo(zw.w), bfhi(zw.w)};
                    const f32x4 x0 = (zf0 * rstd - t) * g0 + b0, x1 = (zf1 * rstd - t) * g1 + b1;
                    const f32x4 a0 = fold4(acc[ai][bj][m][0], rstd, t, ca0, cb0), a1 = fold4(acc[ai][bj][m][1], rstd, t, ca1, cb1);
                    const f32x4 p0 = {bflo(pw.x), bfhi(pw.x), bflo(pw.y), bfhi(pw.y)}, p1 = {bflo(pw.z), bfhi(pw.z), bflo(pw.w), bfhi(pw.w)};
                    f32x4 r0, r1;
#pragma unroll
                    for (int i = 0; i < 4; ++i) { r0[i] = x0[i] + sigmoidf_(a0[i]) * p0[i]; r1[i] = x1[i] + sigmoidf_(a1[i]) * p1[i]; }
                    if (last) { *(f32x4*)(yo + o) = r0; *(f32x4*)(yo + o + 4) = r1; }
                    else *(u32x4*)(XBo + o) = pack8(r0, r1); } }
    }
};
}

#define XB_TMO      128
#define XB_XCNT(j)  (256  + 64 * (j))
#define XB_XSUB(j)  (1280 + 64 * (j))
#define XB_XGEN(j)  (2304 + 64 * (j))
#define XB_TOP      3328
#define XB_TOPGEN   3392
#define XCD_BAR_WORDS 3456
#define XB_SPIN_CAP (1u << 18)
__device__ __forceinline__ unsigned xb_ld(unsigned* p)              { return __hip_atomic_load(p, __ATOMIC_RELAXED, __HIP_MEMORY_SCOPE_AGENT); }
__device__ __forceinline__ unsigned xb_add(unsigned* p, unsigned v) { return __hip_atomic_fetch_add(p, v, __ATOMIC_RELAXED, __HIP_MEMORY_SCOPE_AGENT); }
__device__ __forceinline__ unsigned xb_xcc_id() { return (unsigned)__builtin_amdgcn_s_getreg((3 << 11) | 20) & 0xFu; }
#define XB_SPIN(cond, bar) do { unsigned _sp = 0; while (cond) { __builtin_amdgcn_s_sleep(1); \
    if ((++_sp & 255u) == 0u) { if (xb_ld(&(bar)[XB_TMO])) break; if (_sp > XB_SPIN_CAP) { atomicAdd(&(bar)[XB_TMO], 1u); break; } } } } while (0)
struct XcdBarrier { unsigned* bar; unsigned x; volatile LAS unsigned* st; };
__device__ __forceinline__ XcdBarrier xcd_barrier_post(unsigned* bar, volatile LAS unsigned* st) {
    XcdBarrier b; b.bar = bar; b.x = xb_xcc_id(); b.st = st;
    if (threadIdx.x == 0) (void)xb_add(&bar[XB_XCNT(b.x)], 1u);
    return b;
}
__device__ __forceinline__ void xcd_barrier_complete(unsigned* bar, unsigned x, unsigned& nloc, unsigned& nx) {
    const unsigned G = gridDim.x * gridDim.y * gridDim.z;
    unsigned sum, cnt, mine, sp = 0u;
    for (;;) {
        sum = 0u; cnt = 0u; mine = 0u;
#pragma unroll
        for (unsigned j = 0; j < 16; ++j) { const unsigned c = xb_ld(&bar[XB_XCNT(j)]); sum += c; cnt += (c > 0u) ? 1u : 0u; mine = (j == x) ? c : mine; }
        if (sum == G) break;
        __builtin_amdgcn_s_sleep(1);
        if ((++sp & 255u) == 0u) { if (xb_ld(&bar[XB_TMO])) break; if (sp > XB_SPIN_CAP) { atomicAdd(&bar[XB_TMO], 1u); break; } }
    }
    nloc = mine > 0u ? mine : 1u; nx = cnt > 0u ? cnt : 1u;
}
__device__ __forceinline__ void xcd_barrier(const XcdBarrier& b) {
    asm volatile("s_waitcnt vmcnt(0)" ::: "memory");
    __syncthreads();
    if (threadIdx.x == 0) {
        unsigned* bar = b.bar;
        __builtin_amdgcn_s_waitcnt(0);
        unsigned nloc = b.st[0], nx = b.st[1];
        if (nloc == 0u) { xcd_barrier_complete(bar, b.x, nloc, nx); b.st[0] = nloc; b.st[1] = nx; }
        const unsigned old = xb_add(&bar[XB_XSUB(b.x)], 1u);
        const unsigned gen = old / nloc;
        if (old + 1u == (gen + 1u) * nloc) {
            __builtin_amdgcn_fence(__ATOMIC_RELEASE, "agent");
            asm volatile("s_waitcnt vmcnt(0)" ::: "memory");
            const unsigned og = xb_add(&bar[XB_TOP], 1u);
            const unsigned tg = og / nx;
            if (og + 1u == (tg + 1u) * nx) xb_add(&bar[XB_TOPGEN], 1u);
            else XB_SPIN(xb_ld(&bar[XB_TOPGEN]) == tg, bar);
            __builtin_amdgcn_fence(__ATOMIC_ACQUIRE, "agent");
            xb_add(&bar[XB_XGEN(b.x)], 1u);
            asm volatile("s_waitcnt vmcnt(0)" ::: "memory");
        } else {
            XB_SPIN(xb_ld(&bar[XB_XGEN(b.x)]) == gen, bar);
            __builtin_amdgcn_fence(__ATOMIC_ACQUIRE, "agent");
            asm volatile("s_waitcnt vmcnt(0)" ::: "memory");
        }
    }
    __syncthreads();
}

struct Args { const float* in[29]; float* out; unsigned char* ws; int ph_lo, ph_hi; };
enum { I_XP = 0, I_XS, I_CK, I_CV, I_SPOOL, I_SHG, I_PP, I_PS, I_LNG, I_LNB, I_WG, I_WU, I_WD, I_WPG, I_WPU, I_WINE, I_WOUTE, I_POOLW, I_POOLS,
       I_LQ1, I_LK1, I_LQ2, I_LK2, I_DNG, I_RELB, I_WINO, I_WOUTO, I_HNG, I_LBL };
constexpr size_t O_YP = 0, O_YS = O_YP + (size_t)MP * D, O_KP = O_YS + (size_t)MS * D, O_VP = O_KP + (size_t)MP * DAW, O_KS = O_VP + (size_t)MP * DAW, O_VS = O_KS + (size_t)MS * DAW,
                 O_PLP = O_VS + (size_t)MS * DAW, O_PLS = O_PLP + (size_t)NB_P * 15 * POOLW, O_HGP = O_PLS + (size_t)NB_S * 15 * POOLW, O_HGS = O_HGP + (size_t)NB_P * HGH * 128 * 128,
                 O_END = O_HGS + (size_t)NB_S * HGH * 128 * 128;

__device__ __forceinline__ void tr_item(const float* W, int K, int N, bf16_t* WT, int k0, int n0, int drow0, LAS float* scr, int lane, const float* g, const float* b, float* cv, int ncv) {
#pragma unroll 8
    for (int i = 0; i < 32; ++i) { const int kk = 2 * i + (lane >> 5); scr[kk * 33 + (lane & 31)] = W[(size_t)(k0 + kk) * N + n0 + (lane & 31)]; }
    LDS_WAIT(); asm volatile("" ::: "memory");
    if (g) {
        const int n = lane & 31, kh = (lane >> 5) * 32; float s1 = 0.f, s2 = 0.f;
#pragma unroll 8
        for (int kk = 0; kk < 32; ++kk) { const float w = scr[(kh + kk) * 33 + n]; const float ws_ = w * g[k0 + kh + kk]; const float wr = bflo(cvt_pk_bf16(ws_, 0.f));
            scr[(kh + kk) * 33 + n] = wr; s1 += wr; s2 += w * b[k0 + kh + kk]; }
        s1 += __shfl_xor(s1, 32); s2 += __shfl_xor(s2, 32);
        if (lane < 32) { unsafeAtomicAdd(cv + drow0 + n, s1); unsafeAtomicAdd(cv + ncv + drow0 + n, s2); }
        LDS_WAIT(); asm volatile("" ::: "memory");
    }
    const int c = lane & 7;
#pragma unroll
    for (int j = 0; j < 4; ++j) { const int n = (lane >> 3) + 8 * j; const LAS float* sp = scr + (8 * c) * 33 + n;
        u32x4 o; o.x = cvt_pk_bf16(sp[0 * 33], sp[1 * 33]); o.y = cvt_pk_bf16(sp[2 * 33], sp[3 * 33]); o.z = cvt_pk_bf16(sp[4 * 33], sp[5 * 33]); o.w = cvt_pk_bf16(sp[6 * 33], sp[7 * 33]);
        *(u32x4*)(WT + (size_t)(drow0 + n) * K + k0 + 8 * c) = o; }
    LDS_WAIT(); asm volatile("" ::: "memory");
}
__device__ __forceinline__ void tr_matrix_item(const float* W, int K, int N, bf16_t* WT, int kind, int item, LAS float* scr, int lane, const float* g = nullptr, const float* b = nullptr, float* cv = nullptr, int ncv = 0) {
    const int nblk = N / 32, kb = item / nblk, nb = item % nblk, n0 = 32 * nb;
    const int drow0 = kind == 0 ? n0 : kind == 3 ? (512 * ((n0 & 2047) >> 7) + ((n0 >> 11) >> 1) * 256 + ((n0 >> 11) & 1) * 128 + (n0 & 127))
                                   : (256 * (n0 >> 7) + (n0 & 127) + (kind == 2 ? 128 : 0));
    tr_item(W, K, N, WT, 64 * kb, n0, drow0, scr, lane, g, b, cv, ncv);
}
__device__ __forceinline__ int t5_bucket(int rel) {
    const int n = rel < 0 ? -rel : rel; int b;
    if (n < 8) b = n; else { b = 8 + (n >= 12) + (n >= 16) + (n >= 23) + (n >= 32) + (n >= 46) + (n >= 64) + (n >= 91); }
    return b + (rel > 0 ? 16 : 0);
}
__device__ __forceinline__ void p0_prologue(const Args& a, LAS unsigned char* lds, int vcu, int NGW) {
    int tid = threadIdx.x; asm volatile("" : "+v"(tid)); const int lane = tid & 63, wave = __builtin_amdgcn_readfirstlane(tid >> 6);
    const int gw = vcu * 8 + wave;
    unsigned char* ws = a.ws;
    LAS float* scr = (LAS float*)(lds + wave * 16384);
    constexpr int I_GU = (D / 64) * (FF / 32), I_DN = (FF / 64) * (D / 32), I_INE = (D / 64) * (IN_EVEN / 32), I_SQ = (D / 64) * (D / 32), I_INO = (D / 64) * (IN_ODD / 32), I_PU = (PLE / 64) * (D / 32);
    constexpr int NITEMS = 4 * (2 * I_GU + I_DN) + I_INE + I_SQ + I_INO + I_SQ + 2 * I_SQ + 2 * I_PU;
    constexpr int I_FFN = 2 * I_GU + I_DN;
    for (int it = gw; it < NITEMS; it += NGW) {
        int r = it;
        if (r < 4 * I_FFN) { const int s = r / I_FFN; r -= s * I_FFN;
            bf16_t* wgu = (bf16_t*)(ws + WS_WGU) + (size_t)s * 2 * FF * D; bf16_t* wd = (bf16_t*)(ws + WS_WD) + (size_t)s * D * FF;
            const bool fold = (s & 1) != 0; const float* lg = fold ? a.in[I_LNG] + (size_t)((s >> 1) * 3 + 1) * D : nullptr; const float* lb_ = fold ? a.in[I_LNB] + (size_t)((s >> 1) * 3 + 1) * D : nullptr;
            float* cv = (float*)(ws + WS_C12) + ((s >> 1) ? C_UP1 : C_UP0);
            if (r < I_GU) tr_matrix_item(a.in[I_WG] + (size_t)s * D * FF, D, FF, wgu, 1, r, scr, lane, lg, lb_, cv, 2 * FF);
            else if (r < 2 * I_GU) tr_matrix_item(a.in[I_WU] + (size_t)s * D * FF, D, FF, wgu, 2, r - I_GU, scr, lane, lg, lb_, cv, 2 * FF);
            else tr_matrix_item(a.in[I_WD] + (size_t)s * FF * D, FF, D, wd, 0, r - 2 * I_GU, scr, lane);
            continue; }
        r -= 4 * I_FFN;
        if (r < I_INE) { tr_matrix_item(a.in[I_WINE], D, IN_EVEN, (bf16_t*)(ws + WS_WINE), 0, r, scr, lane, a.in[I_LNG], a.in[I_LNB], (float*)(ws + WS_C12) + C_INE, IN_EVEN); continue; } r -= I_INE;
        if (r < I_SQ) { tr_matrix_item(a.in[I_WOUTE], D, D, (bf16_t*)(ws + WS_WOUTE), 0, r, scr, lane); continue; } r -= I_SQ;
        if (r < I_INO) { tr_matrix_item(a.in[I_WINO], D, IN_ODD, (bf16_t*)(ws + WS_WINO), 3, r, scr, lane, a.in[I_LNG] + (size_t)3 * D, a.in[I_LNB] + (size_t)3 * D, (float*)(ws + WS_C12) + C_INO, IN_ODD); continue; } r -= I_INO;
        if (r < I_SQ) { tr_matrix_item(a.in[I_WOUTO], D, D, (bf16_t*)(ws + WS_WOUTO), 0, r, scr, lane); continue; } r -= I_SQ;
        if (r < I_SQ) { tr_matrix_item(a.in[I_WPG], D, D, (bf16_t*)(ws + WS_WPG), 0, r, scr, lane, a.in[I_LNG] + (size_t)2 * D, a.in[I_LNB] + (size_t)2 * D, (float*)(ws + WS_C12) + C_PG0, D); continue; } r -= I_SQ;
        if (r < I_SQ) { tr_matrix_item(a.in[I_WPG] + (size_t)D * D, D, D, (bf16_t*)(ws + WS_WPG) + (size_t)D * D, 0, r, scr, lane, a.in[I_LNG] + (size_t)5 * D, a.in[I_LNB] + (size_t)5 * D, (float*)(ws + WS_C12) + C_PG1, D); continue; } r -= I_SQ;
        if (r < I_PU) { tr_matrix_item(a.in[I_WPU], PLE, D, (bf16_t*)(ws + WS_WPU), 0, r, scr, lane); continue; } r -= I_PU;
        tr_matrix_item(a.in[I_WPU] + (size_t)PLE * D, PLE, D, (bf16_t*)(ws + WS_WPU) + (size_t)D * PLE, 0, r, scr, lane);
    }
    { const size_t gt = (size_t)gw * 64 + lane, GT = (size_t)NGW * 64; bf16_t* XB = (bf16_t*)(ws + WS_XB2);
      for (size_t i = gt; i < (size_t)M * D / 8; i += GT) { const size_t e = i * 8; const float* src = e < (size_t)MP * D ? a.in[I_XP] + e : a.in[I_XS] + (e - (size_t)MP * D);
          const f32x4 v0 = *(const f32x4*)src, v1 = *(const f32x4*)(src + 4); *(u32x4*)(XB + e) = pg8::pack8(v0, v1); }
      bf16_t* PB = (bf16_t*)(ws + WS_PB);
      for (size_t i = gt; i < (size_t)2 * M * PLE / 8; i += GT) { const size_t e = i * 8; const int l = (int)(e / ((size_t)M * PLE)); const size_t r = e - (size_t)l * M * PLE;
          const float* src = r < (size_t)MP * PLE ? a.in[I_PP] + (size_t)l * MP * PLE + r : a.in[I_PS] + (size_t)l * MS * PLE + (r - (size_t)MP * PLE);
          const f32x4 v0 = *(const f32x4*)src, v1 = *(const f32x4*)(src + 4); *(u32x4*)(PB + e) = pg8::pack8(v0, v1); }
      float* tb = (float*)(ws + WS_TAB + TAB_BIAS);
      for (size_t i = gt; i < (size_t)NH * 256; i += GT) { const int h = (int)(i >> 8), idx = (int)(i & 255); const int rel = idx - 191;
          const float* rb = a.in[I_RELB]; tb[i] = idx < 255 ? (rb[t5_bucket(rel) * NH + h] - rb[15 * NH + h]) * LOG2E : 0.f; }
      float* lbv = (float*)(ws + WS_TAB + TAB_LB);
      for (size_t i = gt; i < (size_t)D; i += GT) { const float l0 = a.in[I_LBL][i], l1 = a.in[I_LBL][D + i]; const float mx = fmaxf(l0, l1), e0 = __expf(l0 - mx), e1 = __expf(l1 - mx); lbv[i] = e1 / (e0 + e1); }
      bf16_t* pwt = (bf16_t*)(ws + WS_TAB + TAB_PWT);
      for (size_t i = gt; i < (size_t)4 * 128 * 128; i += GT) { const int g = (int)(i >> 14), n = (int)((i >> 7) & 127), k = (int)(i & 127);
          pwt[i] = (bf16_t)(cvt_pk_bf16(a.in[I_POOLW][((size_t)g * 128 + k) * 128 + n], 0.f) & 0xffffu); }
    }
}

__device__ __forceinline__ void ln_phase(const float* Z, float* X, bf16_t* XB, const float* g, const float* b, int vcu, int NGW) {
    int tid = threadIdx.x; asm volatile("" : "+v"(tid)); const int lane = tid & 63, wave = __builtin_amdgcn_readfirstlane(tid >> 6);
    const int gw = vcu * 8 + wave;
    f32x4 gv[8], bv[8];
#pragma unroll
    for (int j = 0; j < 8; ++j) { gv[j] = *(const f32x4*)(g + (j * 64 + lane) * 4); bv[j] = *(const f32x4*)(b + (j * 64 + lane) * 4); }
    for (int row = gw; row < M; row += NGW) {
        float* xr = X + (size_t)row * D; const float* zr = Z + (size_t)row * D; f32x4 v[8]; float s = 0.f;
#pragma unroll
        for (int j = 0; j < 8; ++j) { v[j] = *(const f32x4*)(zr + (j * 64 + lane) * 4); s += (v[j][0] + v[j][1]) + (v[j][2] + v[j][3]); }
        const float mean = wave_sum(s) * (1.f / D); float s2 = 0.f;
#pragma unroll
        for (int j = 0; j < 8; ++j) { v[j] = v[j] - mean; s2 += (v[j][0] * v[j][0] + v[j][1] * v[j][1]) + (v[j][2] * v[j][2] + v[j][3] * v[j][3]); }
        const float rstd = 1.f / sqrtf(wave_sum(s2) * (1.f / D) + LN_EPS);
        bf16_t* xb = XB + (size_t)row * D;
#pragma unroll
        for (int j = 0; j < 8; ++j) { const f32x4 o = v[j] * rstd * gv[j] + bv[j]; *(f32x4*)(xr + (j * 64 + lane) * 4) = o;
            u32x2 w; w.x = cvt_pk_bf16(o[0], o[1]); w.y = cvt_pk_bf16(o[2], o[3]); *(u32x2*)(xb + (j * 64 + lane) * 4) = w; }
    }
}

#define KSWZ(row, colB) ((row) * 256 + ((colB) ^ (((row) & 7) << 4)))
__device__ __forceinline__ int crow(int r, int hi) { return (r & 3) + 8 * (r >> 2) + 4 * hi; }
__device__ __forceinline__ void pool_phase(const Args& a, LAS unsigned char* lds) {
    int tid = threadIdx.x; asm volatile("" : "+v"(tid)); const int lane = tid & 63, wave = __builtin_amdgcn_readfirstlane(tid >> 6);
    const float* U = (const float*)(a.ws + WS_U); bf16_t* MIX = (bf16_t*)(a.ws + WS_MIX); const bf16_t* pwt = (const bf16_t*)(a.ws + WS_TAB + TAB_PWT);
    LAS float* full = (LAS float*)lds;
    LAS unsigned char* pa = lds + 40960;
    const int r32 = lane & 31, hi = lane >> 5;
    for (int unit = blockIdx.x; unit < (M / 64) * 4; unit += gridDim.x) {
        const int rb = unit >> 2, g = unit & 3, r0 = rb * 64; const bool smp = r0 >= MP;
        const int t0 = smp ? 0 : (r0 & (SEQ - 1)); const int bs = smp ? (r0 - MP) / DSEQ : 0;
        for (int p = tid; p < 79 * 32; p += 512) { const int i = p >> 5, c4 = (p & 31) * 4; const int t = t0 - 15 + i; f32x4 v = {0.f, 0.f, 0.f, 0.f};
            if (t >= 0) v = *(const f32x4*)(U + (size_t)(r0 - 15 + i) * POOLW + g * 128 + c4);
            else if (smp) v = *(const f32x4*)(a.in[I_SPOOL] + ((size_t)bs * 15 + (15 + t)) * POOLW + g * 128 + c4);
            *(LAS f32x4*)(full + i * 128 + c4) = v; }
        __syncthreads();
        { const int c = tid & 127, rq = tid >> 7, w = 2 << g;
          for (int tt = rq * 16; tt < rq * 16 + 16; ++tt) { float s = 0.f;
              for (int j = 0; j < w; ++j) s += full[(15 + tt - j) * 128 + c];
              const int cnt = smp ? w : ((t0 + tt + 1) < w ? (t0 + tt + 1) : w);
              const float pv = s / (float)cnt - full[(15 + tt) * 128 + c];
              *(LAS bf16_t*)(pa + KSWZ(tt, c * 2)) = (bf16_t)(cvt_pk_bf16(pv, 0.f) & 0xffffu); } }
        __syncthreads();
        { const int rt = wave >> 2, ct = wave & 3; f32x16 acc = {};
#pragma unroll
          for (int s = 0; s < 8; ++s) { const bf16x8 af = *(const LAS bf16x8*)(pa + KSWZ(32 * rt + r32, (16 * s + 8 * hi) * 2));
              const bf16x8 bfr = *(const bf16x8*)(pwt + ((size_t)g * 128 + 32 * ct + r32) * 128 + 16 * s + 8 * hi);
              acc = __builtin_amdgcn_mfma_f32_32x32x16_bf16(af, bfr, acc, 0, 0, 0); }
          const int n = g * 128 + 32 * ct + r32; const float sc = a.in[I_POOLS][n];
#pragma unroll
          for (int r = 0; r < 16; ++r) { const int row = r0 + 32 * rt + crow(r, hi); MIX[(size_t)row * D + n] = (bf16_t)(cvt_pk_bf16(acc[r] * sc, 0.f) & 0xffffu); } }
        __syncthreads();
    }
    { float* op = a.out + O_PLP; float* os = a.out + O_PLS;
      for (int i = blockIdx.x * 512 + tid; i < NB_P * 15 * POOLW; i += gridDim.x * 512) { const int c = i & 511, j = (i >> 9) % 15, b = i / (15 * POOLW); op[i] = U[((size_t)b * SEQ + SEQ - 15 + j) * POOLW + c]; }
      for (int i = blockIdx.x * 512 + tid; i < NB_S * 15 * POOLW; i += gridDim.x * 512) { const int c = i & 511, j = (i >> 9) % 15, b = i / (15 * POOLW); os[i] = U[((size_t)MP + (size_t)b * DSEQ + DSEQ - 15 + j) * POOLW + c]; } }
}

namespace att {
__device__ __forceinline__ int v_st(int k, int c) { const int kk = (k & ~0xC) | ((k & 4) << 1) | ((k & 8) >> 1); return ((kk >> 3) * 4 + (c >> 5)) * 512 + ((kk & 7) * 32 + (c & 31)) * 2; }
__device__ __forceinline__ int v_rd_base(int lane) { return ((lane & 3) << 3) | (((lane >> 2) & 3) << 6) | (((lane >> 4) & 1) << 5) | (((lane >> 5) & 1) << 8); }
constexpr int v_rd_off(int d0, int ks, int half) { return d0 * 512 + ks * 4096 + half * 2048; }
template <int OFF> __device__ __forceinline__ s16x4 tr_read(unsigned vb) { s16x4 r; asm volatile("ds_read_b64_tr_b16 %0, %1 offset:%2" : "=&v"(r) : "v"(vb), "i"(OFF) : "memory"); return r; }
template <int D0, int H> __device__ __forceinline__ void pv_half(f32x16& od, unsigned vb, bf16x8 pa0, bf16x8 pa1) {
    const s16x4 l0 = tr_read<v_rd_off(D0, 2 * H, 0)>(vb), h0 = tr_read<v_rd_off(D0, 2 * H, 1)>(vb), l1 = tr_read<v_rd_off(D0, 2 * H + 1, 0)>(vb), h1 = tr_read<v_rd_off(D0, 2 * H + 1, 1)>(vb);
    asm volatile("s_waitcnt lgkmcnt(0)" ::: "memory"); __builtin_amdgcn_sched_barrier(0);
#define PK(L, H_) (bf16x8){L[0], L[1], L[2], L[3], H_[0], H_[1], H_[2], H_[3]}
    od = __builtin_amdgcn_mfma_f32_32x32x16_bf16(pa0, PK(l0, h0), od, 0, 0, 0);
    od = __builtin_amdgcn_mfma_f32_32x32x16_bf16(pa1, PK(l1, h1), od, 0, 0, 0);
#undef PK
}
__device__ __forceinline__ u32x4 ld_bf8(const bf16_t* p) { return *(const u32x4*)p; }
__device__ __forceinline__ u32x4 ld_f8(const float* p) { const f32x4 a = *(const f32x4*)p, b = *(const f32x4*)(p + 4); return pg8::pack8(a, b); }

__device__ __forceinline__ void scores_h(f32x16& a, f32x16& b, const LAS unsigned char* Ks, int krow, const bf16x8* qr, int hi, bool near, const LAS float* tb, int idx) {
    a = (f32x16){}; b = (f32x16){};
#pragma unroll
    for (int d0 = 0; d0 < 4; ++d0) { const bf16x8 k0 = *(const LAS bf16x8*)(Ks + KSWZ(krow, (d0 * 16 + hi * 8) * 2)); a = __builtin_amdgcn_mfma_f32_32x32x16_bf16(k0, qr[d0], a, 0, 0, 0); }
#pragma unroll
    for (int d0 = 4; d0 < 8; ++d0) { const bf16x8 k0 = *(const LAS bf16x8*)(Ks + KSWZ(krow, (d0 * 16 + hi * 8) * 2)); b = __builtin_amdgcn_mfma_f32_32x32x16_bf16(k0, qr[d0], b, 0, 0, 0); }
    if (near) {
#pragma unroll
        for (int r = 0; r < 16; ++r) { const float v0 = tb[idx + (r & 3) + 8 * (r >> 2)]; a[r] += v0; b[r] += v0; }
    }
}
__device__ __forceinline__ float xhalf_max(float v) { auto rr = __builtin_amdgcn_permlane32_swap(__float_as_uint(v), __float_as_uint(v), false, false); return fmaxf(__uint_as_float(rr[0]), __uint_as_float(rr[1])); }
__device__ __forceinline__ float xhalf_sum(float v) { auto rr = __builtin_amdgcn_permlane32_swap(__float_as_uint(v), __float_as_uint(v), false, false); return __uint_as_float(rr[0]) + __uint_as_float(rr[1]); }
__device__ __forceinline__ void stat_update(float& m, float& l, const f32x16& x) {
    float mx = x[0];
#pragma unroll
    for (int r = 1; r < 16; ++r) mx = fmaxf(mx, x[r]);
    mx = xhalf_max(mx); const float mn = fmaxf(m, mx); float s = 0.f;
#pragma unroll
    for (int r = 0; r < 16; ++r) s += fast_exp2(x[r] - mn);
    l = l * fast_exp2(m - mn) + s; m = mn;
}
#define PK4(P, BASE, OUT) do { unsigned a0_ = cvt_pk_bf16(P[BASE + 0], P[BASE + 1]), a1_ = cvt_pk_bf16(P[BASE + 2], P[BASE + 3]);   \
    unsigned b0_ = cvt_pk_bf16(P[BASE + 4], P[BASE + 5]), b1_ = cvt_pk_bf16(P[BASE + 6], P[BASE + 7]);                              \
    auto r0_ = __builtin_amdgcn_permlane32_swap(a0_, b0_, false, false); auto r1_ = __builtin_amdgcn_permlane32_swap(a1_, b1_, false, false); \
    u32x4 w_ = {r0_[0], r1_[0], r0_[1], r1_[1]}; OUT = __builtin_bit_cast(bf16x8, w_); } while (0)

template <bool SAMPLE>
__device__ __forceinline__ void attn_unit(const Args& a, LAS unsigned char* lds, int uidx, int tid_in, int wave, float lam) {
    int tid = tid_in; asm volatile("" : "+v"(tid));
    const int lane = tid & 63, r32 = lane & 31, hi = lane >> 5;
    const bf16_t* QB = (const bf16_t*)(a.ws + WS_QB); const bf16_t* KB = (const bf16_t*)(a.ws + WS_KB); const bf16_t* VB = (const bf16_t*)(a.ws + WS_VB); bf16_t* MIX = (bf16_t*)(a.ws + WS_MIX);
    LAS float* tb = (LAS float*)(lds + LDS_ATAB);
    int b, h, qb = 0, h0 = 0;
    if (SAMPLE) { b = uidx / 3; h0 = (uidx % 3) * 4; h = h0 + (wave >> 1); }
    else { const int k = uidx; qb = 7 - k / (NB_P * NH); const int bh = k % (NB_P * NH); b = bh / NH; h = bh % NH; }
    const int nsteps = SAMPLE ? 33 : qb + 1;
    const int cw = SAMPLE ? 32 : 4 * qb + (wave >> 1);
    const size_t qrow = SAMPLE ? (size_t)MP + (size_t)b * DSEQ + 32 * (wave & 1) : (size_t)b * SEQ + qb * 256 + 32 * wave;
    if (SAMPLE) { for (int i = tid; i < 1024; i += 512) tb[i] = ((const float*)(a.ws + WS_TAB + TAB_BIAS))[(h0 + (i >> 8)) * 256 + (i & 255)]; }
    else { if (tid < 256) tb[tid] = ((const float*)(a.ws + WS_TAB + TAB_BIAS))[h * 256 + tid]; }
    const LAS float* tbw = tb + (SAMPLE ? 256 * (wave >> 1) : 0);
    bf16x8 qr[8];
    { const bf16_t* qp = QB + (qrow + r32) * DAW + h * HD + hi * 8;
#pragma unroll
      for (int d0 = 0; d0 < 8; ++d0) qr[d0] = *(const bf16x8*)(qp + d0 * 16); }
    const int sr = tid >> 4, sc = (tid & 15) * 8;
    const int kst0 = KSWZ(sr, sc * 2), kst1 = KSWZ(32 + sr, sc * 2), vst0 = v_st(sr, sc), vst1 = v_st(32 + sr, sc);
    float m1 = -1e30f, l1 = 0.f, m2 = -1e30f, l2 = 0.f;
    const int jlo = SAMPLE ? (wave >> 1) : 0, jhi = SAMPLE ? (wave >> 1) : 3;
    const int idxw = -64 * cw - 32 * (wave & 1) - r32 + 191 + 4 * hi;
#define ATT_STAGE(WITHV) do { _Pragma("unroll 1") for (int j = 0; j < 4; ++j) { LAS unsigned char* Ks = lds + j * 32768; LAS unsigned char* Vs = Ks + 16384;                    \
        if (SAMPLE) { const int hh = h0 + j; const float* kp; const float* vp; size_t rs;                                                                                  \
            if (s < 32) { const size_t o_ = (((size_t)b * PAST + 64 * s + sr) * NH + hh) * HD + sc; kp = a.in[I_CK] + o_; vp = a.in[I_CV] + o_; rs = (size_t)32 * NH * HD; }        \
            else { const size_t o_ = ((size_t)b * DSEQ + sr) * DAW + hh * HD + sc; kp = a.out + O_KS + o_; vp = a.out + O_VS + o_; rs = (size_t)32 * DAW; }                      \
            { const u32x4 k0 = ld_f8(kp), k1 = ld_f8(kp + rs); *(LAS u32x4*)(Ks + kst0) = k0; *(LAS u32x4*)(Ks + kst1) = k1; }                                             \
            if (WITHV) { const u32x4 v0 = ld_f8(vp), v1 = ld_f8(vp + rs); *(LAS u32x4*)(Vs + vst0) = v0; *(LAS u32x4*)(Vs + vst1) = v1; }                                    \
        } else { const size_t o_ = ((size_t)b * SEQ + 64 * (4 * s + j) + sr) * DAW + h * HD + sc;                                                                        \
            { const u32x4 k0 = ld_bf8(KB + o_), k1 = ld_bf8(KB + o_ + (size_t)32 * DAW); *(LAS u32x4*)(Ks + kst0) = k0; *(LAS u32x4*)(Ks + kst1) = k1; }                   \
            if (WITHV) { const u32x4 v0 = ld_bf8(VB + o_), v1 = ld_bf8(VB + o_ + (size_t)32 * DAW); *(LAS u32x4*)(Vs + vst0) = v0; *(LAS u32x4*)(Vs + vst1) = v1; } } } } while (0)
#pragma unroll 1
    for (int s = 0; s < nsteps; ++s) {
        ATT_STAGE(false);
        __syncthreads();
#pragma unroll 1
        for (int j = jlo; j <= jhi; ++j) { const int t = SAMPLE ? s : 4 * s + j;
            if (t > cw) break;
            const bool near = t >= cw - 2; const LAS unsigned char* Ks = lds + j * 32768; const int idx = near ? idxw + 64 * t : 0;
#pragma unroll
            for (int hf = 0; hf < 2; ++hf) { f32x16 x, y; scores_h(x, y, Ks, 32 * hf + r32, qr, hi, near, tbw, idx + 32 * hf); stat_update(m1, l1, x); stat_update(m2, l2, y); } }
        __syncthreads();
    }
    const float il1 = fast_rcp(xhalf_sum(l1)), cl2 = lam * fast_rcp(xhalf_sum(l2));
    f32x16 o[4] = {};
#pragma unroll 1
    for (int s = 0; s < nsteps; ++s) {
        ATT_STAGE(true);
        __syncthreads();
#pragma unroll 1
        for (int j = jlo; j <= jhi; ++j) { const int t = SAMPLE ? s : 4 * s + j;
            if (t > cw) break;
            const LAS unsigned char* Ks = lds + j * 32768; const bool near = t >= cw - 2; const int idx = near ? idxw + 64 * t : 0;
            const unsigned vb = (unsigned)(size_t)(Ks + 16384) + (unsigned)v_rd_base(lane);
            { f32x16 x, y; scores_h(x, y, Ks, r32, qr, hi, near, tbw, idx);
#pragma unroll
              for (int r = 0; r < 16; ++r) x[r] = fast_exp2(x[r] - m1) * il1 - fast_exp2(y[r] - m2) * cl2;
              bf16x8 pa0, pa1; PK4(x, 0, pa0); PK4(x, 8, pa1);
              pv_half<0, 0>(o[0], vb, pa0, pa1); pv_half<1, 0>(o[1], vb, pa0, pa1); pv_half<2, 0>(o[2], vb, pa0, pa1); pv_half<3, 0>(o[3], vb, pa0, pa1); }
            { f32x16 x, y; scores_h(x, y, Ks, 32 + r32, qr, hi, near, tbw, idx + 32);
#pragma unroll
              for (int r = 0; r < 16; ++r) x[r] = fast_exp2(x[r] - m1) * il1 - fast_exp2(y[r] - m2) * cl2;
              bf16x8 pa0, pa1; PK4(x, 0, pa0); PK4(x, 8, pa1);
              pv_half<0, 1>(o[0], vb, pa0, pa1); pv_half<1, 1>(o[1], vb, pa0, pa1); pv_half<2, 1>(o[2], vb, pa0, pa1); pv_half<3, 1>(o[3], vb, pa0, pa1); } }
        __syncthreads();
    }
#undef ATT_STAGE
    float ss[16];
#pragma unroll
    for (int r = 0; r < 16; ++r) { float v = o[0][r] * o[0][r] + o[1][r] * o[1][r] + o[2][r] * o[2][r] + o[3][r] * o[3][r];
#pragma unroll
        for (int sft = 1; sft < 32; sft <<= 1) v += __shfl_xor(v, sft);
        ss[r] = (1.f - LAM_INIT) / sqrtf(v * (1.f / HD) + LN_EPS); }
    float gq[4];
#pragma unroll
    for (int d0 = 0; d0 < 4; ++d0) gq[d0] = a.in[I_DNG][32 * d0 + r32];
#pragma unroll
    for (int r = 0; r < 16; ++r) { bf16_t* op = MIX + (qrow + crow(r, hi)) * D + POOLW + h * HD + r32;
#pragma unroll
        for (int d0 = 0; d0 < 4; ++d0) op[32 * d0] = (bf16_t)(cvt_pk_bf16(o[d0][r] * ss[r] * gq[d0], 0.f) & 0xffffu); }
}
constexpr int N_SAMPLE_UNITS = NB_S * 3, N_PROMPT_UNITS = NB_P * NH * 8, N_UNITS = N_SAMPLE_UNITS + N_PROMPT_UNITS;
}

__device__ __forceinline__ void attn_phase(const Args& a, LAS unsigned char* lds, int rep) {
    int tid = threadIdx.x; asm volatile("" : "+v"(tid)); const int lane = tid & 63, wave = __builtin_amdgcn_readfirstlane(tid >> 6);
    float lam;
    { const float p1 = a.in[I_LQ1][lane] * a.in[I_LK1][lane], p2 = a.in[I_LQ2][lane] * a.in[I_LK2][lane]; lam = __expf(wave_sum(p1)) - __expf(wave_sum(p2)) + LAM_INIT; }
    unsigned* qhead = (unsigned*)(a.ws + WS_CTL) + CW_QATT + 64 * rep;
    volatile LAS unsigned* bc = (volatile LAS unsigned*)(lds + LDS_MISC + 64);
    for (;;) {
        if (tid == 0) *bc = atomicAdd(qhead, 1u);
        __syncthreads();
        const int u = (int)*bc;
        __syncthreads();
        if (u >= att::N_UNITS) break;
        if (u < att::N_SAMPLE_UNITS) att::attn_unit<true>(a, lds, u, tid, wave, lam);
        else att::attn_unit<false>(a, lds, u - att::N_SAMPLE_UNITS, tid, wave, lam);
    }
}

namespace hg {
constexpr int SLOT = 21504, NSLOT = 5, OT = NSLOT * SLOT;
__device__ __forceinline__ s16x4 trr(unsigned addr) { s16x4 r; asm volatile("ds_read_b64_tr_b16 %0, %1" : "=&v"(r) : "v"(addr) : "memory"); return r; }
#define DPP_ROR(v, n) __builtin_bit_cast(float, __builtin_amdgcn_update_dpp(0, __builtin_bit_cast(int, v), 0x120 + (n), 0xf, 0xf, false))
__device__ __forceinline__ float sum16(float x) { x += DPP_ROR(x, 8); x += DPP_ROR(x, 4); x += DPP_ROR(x, 2); x += DPP_ROR(x, 1); return x; }
#undef DPP_ROR
}
__device__ __forceinline__ void hgrn_phase(const Args& a, LAS unsigned char* lds) {
    int tid = threadIdx.x; asm volatile("" : "+v"(tid)); const int lane = tid & 63, w = __builtin_amdgcn_readfirstlane(tid >> 6);
    const int g = lane >> 4, el = lane & 15;
    unsigned srcoff[5]; int dstoff[5];
#pragma unroll
    for (int i = 0; i < 5; ++i) { const int piece = 5 * (w & 3) + i, arr = piece >> 2, rg = piece & 3, row = 4 * rg + g;
        const unsigned abase = arr == 0 ? 0u : arr == 1 ? (unsigned)(WS_KI - WS_QE) : arr == 2 ? (unsigned)(WS_KD - WS_QE) : arr == 3 ? (unsigned)(WS_VV - WS_QE) : (unsigned)(WS_GG - WS_QE);
        srcoff[i] = abase + (unsigned)row * (D * 2) + (unsigned)((el ^ row) << 4); dstoff[i] = arr * 4096 + rg * 1024; }
    const unsigned aq0 = (unsigned)(el * 256 + 8 * (g & 1)), aqx = (unsigned)(g >> 1);
    const int tk = 4 * g + (el >> 2), pp = el & 3;
    const unsigned atr = (unsigned)(tk * 256 + 8 * (pp & 1));
    const int ftok = 4 * (w & 3) + g;
    const f32x4 gn0 = *(const f32x4*)(a.in[I_HNG] + 8 * el), gn1 = *(const f32x4*)(a.in[I_HNG] + 8 * el + 4);
    for (int unit = blockIdx.x; unit < NB_P * HGH + NB_S * HGH; unit += gridDim.x) {
        const bool smp = unit >= NB_P * HGH; const int bh = smp ? unit - NB_P * HGH : unit; const int b = bh >> 4, h = bh & 15;
        const int NC = smp ? DSEQ / 16 : SEQ / 16; const size_t row0 = smp ? (size_t)MP + (size_t)b * DSEQ : (size_t)b * SEQ;
        f32x4 S[8];
        if (smp) { const float* sp = a.in[I_SHG] + (((size_t)b * HGH + h) * 128 + 4 * g) * 128 + 16 * w + el;
#pragma unroll
            for (int mt = 0; mt < 8; ++mt)
#pragma unroll
                for (int r = 0; r < 4; ++r) S[mt][r] = sp[(size_t)(16 * mt + r) * 128]; }
        else {
#pragma unroll
            for (int mt = 0; mt < 8; ++mt) S[mt] = (f32x4){0.f, 0.f, 0.f, 0.f}; }
        const unsigned char* ubase = a.ws + WS_QE + row0 * (D * 2) + (size_t)h * 256;
        const float* ebase = (const float*)(a.ws + WS_EB) + (row0 >> 4) * D + h * 128 + (lane & 31) * 4;
        bf16_t* obase = (bf16_t*)(a.ws + WS_MIX) + (row0 + ftok) * D + h * 128 + 8 * el;
        asm volatile("s_waitcnt vmcnt(0)" ::: "memory");
#pragma unroll
        for (int mt = 0; mt < 8; ++mt) asm volatile("" : "+v"(S[mt]));
#define HG_DMA(c, slotp) do { if (w < 4) { const int cc_ = (c) < NC ? (c) : NC - 1; const unsigned char* ub_ = ubase + (size_t)cc_ * (16 * D * 2);                     \
        _Pragma("unroll") for (int i_ = 0; i_ < 5; ++i_) __builtin_amdgcn_global_load_lds((const unsigned*)(ub_ + srcoff[i_]), (LAS unsigned*)((slotp) + dstoff[i_]), 16, 0, 0);     \
        if (w == 0) __builtin_amdgcn_global_load_lds((const unsigned*)(ebase + (size_t)cc_ * D), (LAS unsigned*)((slotp) + 20480), 16, 0, 0); } } while (0)
        HG_DMA(0, lds); HG_DMA(1, lds + hg::SLOT); HG_DMA(2, lds + 2 * hg::SLOT);
        int si = 0;
#pragma unroll 1
        for (int c = 0; c <= NC; ++c) {
            if (w == 0) asm volatile("s_waitcnt vmcnt(12)" ::: "memory"); else if (w < 4) asm volatile("s_waitcnt vmcnt(10)" ::: "memory");
            asm volatile("s_waitcnt lgkmcnt(0)" ::: "memory"); __builtin_amdgcn_s_barrier(); asm volatile("" ::: "memory");
            { const int s3 = si + 3 >= hg::NSLOT ? si + 3 - hg::NSLOT : si + 3; HG_DMA(c + 3, lds + s3 * hg::SLOT); }
            const LAS unsigned char* sl = lds + si * hg::SLOT; const unsigned slb = (unsigned)(size_t)sl;
            if (c < NC) {
                f32x4 oacc = {0.f, 0.f, 0.f, 0.f};
                bf16x8 qf[4];
#pragma unroll
                for (int ks = 0; ks < 4; ++ks) { const unsigned c0 = (unsigned)(4 * ks) + aqx;
                    const u32x2 lo = *(const LAS u32x2*)(sl + aq0 + (((c0) ^ (unsigned)el) << 4)), hi2 = *(const LAS u32x2*)(sl + aq0 + (((c0 + 2) ^ (unsigned)el) << 4));
                    u32x4 qv = {lo.x, lo.y, hi2.x, hi2.y}; qf[ks] = __builtin_bit_cast(bf16x8, qv);
                    u32x4 sv = {cvt_pk_bf16(S[2 * ks][0], S[2 * ks][1]), cvt_pk_bf16(S[2 * ks][2], S[2 * ks][3]), cvt_pk_bf16(S[2 * ks + 1][0], S[2 * ks + 1][1]), cvt_pk_bf16(S[2 * ks + 1][2], S[2 * ks + 1][3])};
                    oacc = __builtin_amdgcn_mfma_f32_16x16x32_bf16(qf[ks], __builtin_bit_cast(bf16x8, sv), oacc, 0, 0, 0); }
                f32x4 at = {0.f, 0.f, 0.f, 0.f};
#pragma unroll
                for (int ks = 0; ks < 4; ++ks) { const unsigned c0 = (unsigned)(4 * ks) + aqx;
                    const u32x2 lo = *(const LAS u32x2*)(sl + 4096 + aq0 + (((c0) ^ (unsigned)el) << 4)), hi2 = *(const LAS u32x2*)(sl + 4096 + aq0 + (((c0 + 2) ^ (unsigned)el) << 4));
                    u32x4 kv = {lo.x, lo.y, hi2.x, hi2.y};
                    at = __builtin_amdgcn_mfma_f32_16x16x32_bf16(__builtin_bit_cast(bf16x8, kv), qf[ks], at, 0, 0, 0); }
#pragma unroll
                for (int r = 0; r < 4; ++r) at[r] = (4 * g + r <= el) ? at[r] : 0.f;
                const s16x4 vt = hg::trr(slb + 12288 + atr + ((((unsigned)(2 * w) + (unsigned)(pp >> 1)) ^ (unsigned)tk) << 4));
                s16x4 kt[8];
#pragma unroll
                for (int mt = 0; mt < 8; ++mt) kt[mt] = hg::trr(slb + 8192 + atr + ((((unsigned)(2 * mt) + (unsigned)(pp >> 1)) ^ (unsigned)tk) << 4));
                asm volatile("s_waitcnt lgkmcnt(0)" ::: "memory"); __builtin_amdgcn_sched_barrier(0);
                const bf16x8 vfr = {vt[0], vt[1], vt[2], vt[3], 0, 0, 0, 0};
                { u32x4 av = {cvt_pk_bf16(at[0], at[1]), cvt_pk_bf16(at[2], at[3]), 0u, 0u};
                  oacc = __builtin_amdgcn_mfma_f32_16x16x32_bf16(__builtin_bit_cast(bf16x8, av), vfr, oacc, 0, 0, 0); }
#pragma unroll
                for (int mt = 0; mt < 8; ++mt) { const f32x4 e4 = *(const LAS f32x4*)(sl + 20480 + (16 * mt + 4 * g) * 4);
                    const bf16x8 kfr = {kt[mt][0], kt[mt][1], kt[mt][2], kt[mt][3], 0, 0, 0, 0};
                    S[mt] = __builtin_amdgcn_mfma_f32_16x16x32_bf16(kfr, vfr, S[mt] * e4, 0, 0, 0); }
                LAS float* ot = (LAS float*)(lds + hg::OT + (c & 1) * 8192) + (4 * g) * 128 + 16 * w + el;
#pragma unroll
                for (int r = 0; r < 4; ++r) ot[r * 128] = oacc[r];
            }
            if (w >= 4 && c > 0) {
                const int sp = si == 0 ? hg::NSLOT - 1 : si - 1;
                const LAS float* ot = (const LAS float*)(lds + hg::OT + ((c - 1) & 1) * 8192) + ftok * 128 + 8 * el;
                const f32x4 o0 = *(const LAS f32x4*)ot, o1 = *(const LAS f32x4*)(ot + 4);
                const u32x4 gw = *(const LAS u32x4*)(lds + sp * hg::SLOT + 16384 + ftok * 256 + ((el ^ ftok) << 4));
                float ssq = (o0[0] * o0[0] + o0[1] * o0[1]) + (o0[2] * o0[2] + o0[3] * o0[3]) + (o1[0] * o1[0] + o1[1] * o1[1]) + (o1[2] * o1[2] + o1[3] * o1[3]);
                ssq = hg::sum16(ssq); const float rstd = 1.f / sqrtf(ssq * (1.f / 128) + LN_EPS);
                const f32x4 g0 = {bflo(gw.x), bfhi(gw.x), bflo(gw.y), bfhi(gw.y)}, g1 = {bflo(gw.z), bfhi(gw.z), bflo(gw.w), bfhi(gw.w)};
                *(u32x4*)(obase + (size_t)(16 * (c - 1)) * D) = pg8::pack8(o0 * rstd * gn0 * g0, o1 * rstd * gn1 * g1);
            }
            si = si + 1 >= hg::NSLOT ? 0 : si + 1;
        }
#undef HG_DMA
        asm volatile("s_waitcnt vmcnt(0)" ::: "memory");
        { float* sp = a.out + (smp ? O_HGS : O_HGP) + (((size_t)b * HGH + h) * 128 + 4 * g) * 128 + 16 * w + el;
#pragma unroll
          for (int mt = 0; mt < 8; ++mt)
#pragma unroll
              for (int r = 0; r < 4; ++r) sp[(size_t)(16 * mt + r) * 128] = S[mt][r]; }
        asm volatile("s_waitcnt vmcnt(0) lgkmcnt(0)" ::: "memory"); __builtin_amdgcn_s_barrier(); asm volatile("" ::: "memory");
    }
}

constexpr int N_PHASES = 19;
__global__ void __launch_bounds__(512, 2) fwd(Args a) {
    extern __shared__ __attribute__((aligned(16))) unsigned char lds_raw[];
    LAS unsigned char* lds = (LAS unsigned char*)lds_raw;
    const int tid = threadIdx.x;
    const int G = gridDim.x; const int vcu = (G % 8 == 0) ? ((int)blockIdx.x % 8) * (G / 8) + (int)blockIdx.x / 8 : (int)blockIdx.x;
    const int NGW = G * 8;
    for (int u = tid; u < 64; u += 512) ((LAS unsigned*)(lds + LDS_MISC))[u] = 0u;
    __syncthreads();
#if MK_ONE_LAUNCH
    XcdBarrier bar = xcd_barrier_post((unsigned*)(a.ws + WS_CTL) + CW_BAR, (volatile LAS unsigned*)(lds + LDS_MISC + 32));
#define GRID_BAR() xcd_barrier(bar)
#else
#define GRID_BAR() do {} while (0)
#endif
    const int lo = a.ph_lo, hi = a.ph_hi;
#ifndef PHASE_MASK
#define PHASE_MASK 0xFFFF
#endif
#define KIND(n) (((PHASE_MASK) >> (n)) & 1)
#define IN(k) (lo <= (k) && (k) < hi)
#define SEAM(k) do { if (IN(k) && IN((k) + 1)) GRID_BAR(); } while (0)
#define WSP(T, off) ((T*)(wsp_() + (off)))
    auto wsp_ = [&]() -> unsigned char* { unsigned char* p_ = a.ws; asm volatile("" : "+s"(p_)); return p_; };
#define X WSP(float, WS_X)
#define XB WSP(bf16_t, WS_XB)
#define XB2 WSP(bf16_t, WS_XB2)
#define H WSP(bf16_t, WS_H)
#define MIX WSP(bf16_t, WS_MIX)
#define PU WSP(bf16_t, WS_PU)
#define STAT(i) (WSP(float, WS_STATS) + (size_t)(i) * M * 2)
#define CV(off) (WSP(float, WS_C12) + (off))

    if (KIND(0) && IN(0)) { for (int rep = 0; rep < REP_P0; ++rep) p0_prologue(a, lds, vcu, NGW); } SEAM(0);

#pragma unroll 1
    for (int l = 0; l < 2; ++l) {
        const int pb = 1 + 9 * l;
        const float* lng = a.in[I_LNG] + (size_t)l * 3 * D; const float* lnb = a.in[I_LNB] + (size_t)l * 3 * D;
#pragma unroll 1
        for (int j = 0; j < 2; ++j) {
            const int p = pb + 5 * j; const int s = 2 * l + j;
            if (KIND(1) && IN(p)) { pg8::Gemm g{j == 0 ? XB2 : XB, (const bf16_t*)(wsp_() + WS_WGU) + (size_t)s * 2 * FF * D, M, 2 * FF, D}; pg8::StaticOrder S; S.init(M, 2 * FF, G, (int)blockIdx.x);
                pg8::EpiFfnUp E{H, j == 0 ? nullptr : STAT(3 * l + 1), CV(l == 0 ? C_UP0 : C_UP1)};
                for (int rep = 0; rep < REP_UP; ++rep) pg8::gemm_phase<pg8::EpiFfnUp, pg8::StaticOrder, true, true>(lds, g, S, E); }
            SEAM(p);
            if (KIND(2) && IN(p + 1)) { pg8::Gemm g{H, (const bf16_t*)(wsp_() + WS_WD) + (size_t)s * D * FF, M, D, FF}; pg8::StaticOrder S; S.init(M, D, G, (int)blockIdx.x);
                const bool first = (l == 0 && j == 0);
                pg8::EpiResid E{a.in[I_XP], a.in[I_XS], first ? nullptr : (j == 0 ? XB2 : XB), XB, j == 0 ? nullptr : STAT(3 * l + 1), lng + D, lnb + D, STAT(3 * l + 2 * j), ALPHA, 0.5f};
                pg8::gemm_phase<pg8::EpiResid, pg8::StaticOrder, true, true>(lds, g, S, E); }
            SEAM(p + 1);
            if (j == 0) {
                if (l == 0) {
                    if (KIND(4) && IN(pb + 2)) { pg8::Gemm g{XB, (const bf16_t*)(wsp_() + WS_WINE), M, IN_EVEN, D}; pg8::StaticOrder S; S.init(M, IN_EVEN, G, (int)blockIdx.x);
                        pg8::EpiInEven E{(float*)(wsp_() + WS_U), (bf16_t*)(wsp_() + WS_QB), (bf16_t*)(wsp_() + WS_KB), (bf16_t*)(wsp_() + WS_VB), a.out + O_KP, a.out + O_KS, a.out + O_VP, a.out + O_VS, STAT(0), CV(C_INE)};
                        for (int rep = 0; rep < REP_INE; ++rep) pg8::gemm_phase<pg8::EpiInEven, pg8::StaticOrder, true, true>(lds, g, S, E); }
                    SEAM(pb + 2);
                    if (IN(pb + 3)) { if (KIND(5)) for (int rep = 0; rep < REP_ATT; ++rep) attn_phase(a, lds, rep); if (KIND(6)) for (int rep = 0; rep < REP_POOL; ++rep) pool_phase(a, lds); }
                    SEAM(pb + 3);
                } else {
                    if (KIND(7) && IN(pb + 2)) { pg8::Gemm g{XB, (const bf16_t*)(wsp_() + WS_WINO), M, IN_ODD, D}; pg8::StaticOrder S; S.init(M, IN_ODD, G, (int)blockIdx.x);
                        pg8::EpiInOdd E{wsp_(), (const float*)(wsp_() + WS_TAB + TAB_LB), STAT(3), CV(C_INO)};
                        pg8::gemm_phase<pg8::EpiInOdd, pg8::StaticOrder, true, true>(lds, g, S, E); }
                    SEAM(pb + 2);
                    if (KIND(8) && IN(pb + 3)) for (int rep = 0; rep < REP_HG; ++rep) hgrn_phase(a, lds);
                    SEAM(pb + 3);
                }
                if (KIND(9) && IN(pb + 4)) { pg8::Gemm g{MIX, (const bf16_t*)(wsp_() + (l == 0 ? WS_WOUTE : WS_WOUTO)), M, D, D}; pg8::StaticOrder S; S.init(M, D, G, (int)blockIdx.x);
                    pg8::EpiResid E{nullptr, nullptr, XB, XB, STAT(3 * l), lng, lnb, STAT(3 * l + 1), ALPHA, 1.0f};
                    pg8::gemm_phase<pg8::EpiResid, pg8::StaticOrder, true, true>(lds, g, S, E); }
                SEAM(pb + 4);
            }
        }
        if (KIND(10) && IN(pb + 7)) { pg8::Gemm g{(const bf16_t*)(wsp_() + WS_PB) + (size_t)l * M * PLE, (const bf16_t*)(wsp_() + WS_WPU) + (size_t)l * D * PLE, M, D, PLE}; pg8::StaticOrder S; S.init(M, D, G, (int)blockIdx.x);
            pg8::EpiBf16 E{PU, D}; pg8::gemm_phase<pg8::EpiBf16, pg8::StaticOrder, true, true>(lds, g, S, E); }
        SEAM(pb + 7);
        if (KIND(11) && IN(pb + 8)) { pg8::Gemm g{XB, (const bf16_t*)(wsp_() + WS_WPG) + (size_t)l * D * D, M, D, D}; pg8::StaticOrder S; S.init(M, D, G, (int)blockIdx.x);
            pg8::EpiPle E{XB, XB2, PU, a.out + O_YP, a.out + O_YS, STAT(3 * l + 2), CV(l == 0 ? C_PG0 : C_PG1), lng + 2 * D, lnb + 2 * D, l == 1 ? 1 : 0};
            pg8::gemm_phase<pg8::EpiPle, pg8::StaticOrder, true, true>(lds, g, S, E); }
        SEAM(pb + 8);
    }
#undef IN
#undef SEAM
#undef X
#undef XB
#undef XB2
#undef H
#undef MIX
#undef PU
#undef STAT
#undef CV
#undef WSP
}

extern "C" void kernel_launch(void* const* d_in, const int* in_sizes, int n_in, void* d_out, int out_size, void* d_ws, size_t ws_size, hipStream_t stream) {
    static int grid = 0;
    if (grid == 0) {
        if (n_in != 29 || (size_t)out_size != O_END || ws_size < WS_END) { fprintf(stderr, "kernel_launch: shape mismatch: n_in %d out %d (want %zu) ws %zu (want >= %zu)\n", n_in, out_size, (size_t)O_END, ws_size, (size_t)WS_END); grid = -1; return; }
        int dev = 0, cus = 0, per_cu = 0;
        if (hipGetDevice(&dev) != hipSuccess || hipDeviceGetAttribute(&cus, hipDeviceAttributeMultiprocessorCount, dev) != hipSuccess) { fprintf(stderr, "kernel_launch: device query failed\n"); grid = -1; return; }
        if (hipFuncSetAttribute((const void*)fwd, hipFuncAttributeMaxDynamicSharedMemorySize, LDS_BYTES) != hipSuccess) { fprintf(stderr, "kernel_launch: hipFuncSetAttribute failed\n"); grid = -1; return; }
        if (hipOccupancyMaxActiveBlocksPerMultiprocessor(&per_cu, (const void*)fwd, 512, LDS_BYTES) != hipSuccess || per_cu < 1) fprintf(stderr, "kernel_launch: occupancy query reports %d blocks per CU\n", per_cu);
        (void)hipGetLastError();
        grid = cus;
    }
    if (grid < 0) return;
    if (hipMemsetAsync((char*)d_ws + WS_CTL, 0, CTL_ZERO_BYTES, stream) != hipSuccess) { fprintf(stderr, "kernel_launch: memset failed\n"); return; }
    Args a{};
    for (int i = 0; i < 29; ++i) a.in[i] = (const float*)d_in[i];
    a.out = (float*)d_out; a.ws = (unsigned char*)d_ws;
#if MK_ONE_LAUNCH
    a.ph_lo = 0; a.ph_hi = N_PHASES;
    hipLaunchKernelGGL(fwd, dim3(grid), dim3(512), LDS_BYTES, stream, a);
#else
    for (int p = 0; p < N_PHASES; ++p) { a.ph_lo = p; a.ph_hi = p + 1; hipLaunchKernelGGL(fwd, dim3(grid), dim3(512), LDS_BYTES, stream, a); }
#endif
    const hipError_t le = hipPeekAtLastError();
    if (le != hipSuccess) fprintf(stderr, "kernel_launch: launch failed: %s\n", hipGetErrorName(le));
}
```
